# Optimizing an MI355X kernel written in HIP

```python
import math
import jax, jax.numpy as jnp
from jax import lax
import numpy as np

D_MODEL = 1024
BATCH = 16
SEQ = 2048
DEPTH = 1
DEC_BATCH = 8
DEC_SEQ = 4096
PAST_LEN = 128

MIX_WIDTH = D_MODEL
ATT_WIDTH = MIX_WIDTH // 2
LRU_WIDTH = MIX_WIDTH - ATT_WIDTH
N_ATT_HEADS = 4
HEAD_DV = ATT_WIDTH // N_ATT_HEADS
HEAD_DK = HEAD_DV // 2
QK_WIDTH = N_ATT_HEADS * 2 * HEAD_DK
N_LRU_BLOCKS = 8
LRU_BLOCK = LRU_WIDTH // N_LRU_BLOCKS
CONV_W = 4
CONV_PAD_L = 2
RG_C = 8.0
D_FF = ((8 * D_MODEL // 3 + 255) // 256) * 256
IN_WIDTH = 2 * QK_WIDTH + ATT_WIDTH + 2 * LRU_WIDTH
Q_BLOCK = 128
NORM_EPS = 1e-6

kernel_name = "hymba_diffattn_rglru_encoder"


def rmsnorm(x, g):
    xf = x.astype(jnp.float32)
    y = xf * lax.rsqrt(jnp.mean(xf * xf, axis=-1, keepdims=True) + NORM_EPS)
    return (y * g.astype(jnp.float32)).astype(x.dtype)


def alibi_slopes(n):
    return jnp.asarray([2.0 ** (-8.0 * (h + 1) / n) for h in range(n)], dtype=jnp.float32)


def diff_attention(q, k, v, lam):
    B, S = q.shape[0], q.shape[1]
    nb = S // Q_BLOCK
    scale = 1.0 / math.sqrt(HEAD_DK)
    slopes = alibi_slopes(N_ATT_HEADS)
    qb = q.reshape(B, nb, Q_BLOCK, N_ATT_HEADS, 2, HEAD_DK).transpose(1, 0, 2, 3, 4, 5)
    starts = jnp.arange(nb, dtype=jnp.int32) * Q_BLOCK
    kpos = jnp.arange(S, dtype=jnp.int32)

    def block(args):
        qblk, start = args
        s = jnp.einsum('bqhmd,bkhmd->bhmqk', qblk, k,
                       preferred_element_type=jnp.float32) * scale
        qpos = start + jnp.arange(Q_BLOCK, dtype=jnp.int32)
        dist = jnp.abs(qpos[:, None] - kpos[None, :]).astype(jnp.float32)
        s = s - slopes[None, :, None, None, None] * dist[None, None, None]
        p = jax.nn.softmax(s, axis=-1)
        w = p[:, :, 0] - lam * p[:, :, 1]
        return jnp.einsum('bhqk,bkhd->bqhd', w.astype(v.dtype), v)

    o = lax.map(block, (qb, starts))
    return o.transpose(1, 0, 2, 3, 4).reshape(B, S, N_ATT_HEADS, HEAD_DV)


def centred_dwconv(x, w, b):
    S = x.shape[1]
    xp = jnp.pad(x, ((0, 0), (CONV_PAD_L, CONV_W - 1 - CONV_PAD_L), (0, 0)))
    out = xp[:, 0:S] * w[0]
    for j in range(1, CONV_W):
        out = out + xp[:, j:j + S] * w[j]
    return out + b


def _lin_combine(left, right):
    a1, b1 = left
    a2, b2 = right
    return a1 * a2, a2 * b1 + b2


def rg_lru(x, w_r, b_r, w_i, b_i, lam, reverse):
    B, S, W = x.shape
    xf = x.astype(jnp.float32)
    xb = xf.reshape(B, S, N_LRU_BLOCKS, LRU_BLOCK)
    r = jax.nn.sigmoid(jnp.einsum('bsnc,ncd->bsnd', xb, w_r.astype(jnp.float32)).reshape(B, S, W)
                       + b_r.astype(jnp.float32))
    i = jax.nn.sigmoid(jnp.einsum('bsnc,ncd->bsnd', xb, w_i.astype(jnp.float32)).reshape(B, S, W)
                       + b_i.astype(jnp.float32))
    log_a = -RG_C * r * jax.nn.softplus(-lam.astype(jnp.float32))
    a = jnp.exp(log_a)
    mult = jnp.sqrt(jnp.maximum(-jnp.expm1(2.0 * log_a), 1e-12))
    bterm = mult * (i * xf)
    _, h = lax.associative_scan(_lin_combine, (a, bterm), axis=1, reverse=reverse)
    return h


def encoder_layer(x, layer, norm_mix, w_in, conv_w, conv_b, w_rg, b_rg, w_ig, b_ig,
                  lru_lambda, lambda_q1, lambda_k1, lambda_q2, lambda_k2, subln_g,
                  w_out, norm_ffn, w_gate, w_up, w_down):
    B, S, _ = x.shape
    lam_init = 0.8 - 0.6 * math.exp(-0.3 * layer)
    h = rmsnorm(x, norm_mix)
    proj = h @ w_in
    q, k, v, xr, gate = jnp.split(
        proj, [QK_WIDTH, 2 * QK_WIDTH, 2 * QK_WIDTH + ATT_WIDTH,
               2 * QK_WIDTH + ATT_WIDTH + LRU_WIDTH], axis=-1)
    q = q.reshape(B, S, N_ATT_HEADS, 2, HEAD_DK)
    k = k.reshape(B, S, N_ATT_HEADS, 2, HEAD_DK)
    v = v.reshape(B, S, N_ATT_HEADS, HEAD_DV)
    f32 = jnp.float32
    lam = (jnp.exp(jnp.sum(lambda_q1.astype(f32) * lambda_k1.astype(f32)))
           - jnp.exp(jnp.sum(lambda_q2.astype(f32) * lambda_k2.astype(f32))) + lam_init)
    o = diff_attention(q, k, v, lam)
    o = rmsnorm(o, subln_g) * (1.0 - lam_init)
    o = o.reshape(B, S, ATT_WIDTH)
    xc = centred_dwconv(xr, conv_w, conv_b)
    hl = (rg_lru(xc, w_rg[0], b_rg[0], w_ig[0], b_ig[0], lru_lambda[0], False)
          + rg_lru(xc, w_rg[1], b_rg[1], w_ig[1], b_ig[1], lru_lambda[1], True))
    y_lru = hl.astype(x.dtype) * jax.nn.gelu(gate)
    x = x + jnp.concatenate([o.astype(x.dtype), y_lru], axis=-1) @ w_out
    h2 = rmsnorm(x, norm_ffn)
    x = x + (jax.nn.silu(h2 @ w_gate) * (h2 @ w_up)) @ w_down
    return x


def run_trunk(x, norm_mix, w_in, conv_w, conv_b, w_rg, b_rg, w_ig, b_ig, lru_lambda,
              lambda_q1, lambda_k1, lambda_q2, lambda_k2, subln_g, w_out, norm_ffn,
              w_gate, w_up, w_down, norm_final):
    for l in range(DEPTH):
        x = encoder_layer(x, l, norm_mix[l], w_in[l], conv_w[l], conv_b[l], w_rg[l], b_rg[l],
                          w_ig[l], b_ig[l], lru_lambda[l], lambda_q1[l], lambda_k1[l],
                          lambda_q2[l], lambda_k2[l], subln_g[l], w_out[l], norm_ffn[l],
                          w_gate[l], w_up[l], w_down[l])
    return rmsnorm(x, norm_final)


def setup_inputs(seed: int = 0) -> dict:
    key = jax.random.key(seed)
    ks = jax.random.split(key, 24)
    f32 = jnp.float32
    nrm = lambda k, shape, s: jax.random.normal(k, shape, f32) * s
    a8 = jax.random.uniform(ks[12], (DEPTH, 2, LRU_WIDTH), f32, 0.9, 0.999)
    a = a8 ** (1.0 / RG_C)
    lru_lambda = jnp.log(a) - jnp.log1p(-a)
    return {
        "x_prompt": nrm(ks[0], (BATCH, SEQ, D_MODEL), 1.0),
        "x_sample": nrm(ks[1], (DEC_BATCH, DEC_SEQ, D_MODEL), 1.0),
        "norm_mix": 1.0 + nrm(ks[2], (DEPTH, D_MODEL), 0.02),
        "w_in": nrm(ks[3], (DEPTH, D_MODEL, IN_WIDTH), D_MODEL ** -0.5),
        "conv_w": nrm(ks[4], (DEPTH, CONV_W, LRU_WIDTH), CONV_W ** -0.5),
        "conv_b": nrm(ks[5], (DEPTH, LRU_WIDTH), 0.02),
        "w_rg": nrm(ks[6], (DEPTH, 2, N_LRU_BLOCKS, LRU_BLOCK, LRU_BLOCK), LRU_BLOCK ** -0.5),
        "b_rg": nrm(ks[7], (DEPTH, 2, LRU_WIDTH), 0.02),
        "w_ig": nrm(ks[8], (DEPTH, 2, N_LRU_BLOCKS, LRU_BLOCK, LRU_BLOCK), LRU_BLOCK ** -0.5),
        "b_ig": nrm(ks[9], (DEPTH, 2, LRU_WIDTH), 0.02),
        "lru_lambda": lru_lambda,
        "lambda_q1": nrm(ks[10], (DEPTH, HEAD_DK), 0.1),
        "lambda_k1": nrm(ks[11], (DEPTH, HEAD_DK), 0.1),
        "lambda_q2": nrm(ks[13], (DEPTH, HEAD_DK), 0.1),
        "lambda_k2": nrm(ks[14], (DEPTH, HEAD_DK), 0.1),
        "subln_g": 1.0 + nrm(ks[15], (DEPTH, HEAD_DV), 0.02),
        "w_out": nrm(ks[16], (DEPTH, MIX_WIDTH, D_MODEL), MIX_WIDTH ** -0.5),
        "norm_ffn": 1.0 + nrm(ks[17], (DEPTH, D_MODEL), 0.02),
        "w_gate": nrm(ks[18], (DEPTH, D_MODEL, D_FF), D_MODEL ** -0.5),
        "w_up": nrm(ks[19], (DEPTH, D_MODEL, D_FF), D_MODEL ** -0.5),
        "w_down": nrm(ks[20], (DEPTH, D_FF, D_MODEL), D_FF ** -0.5),
        "norm_final": 1.0 + nrm(ks[21], (D_MODEL,), 0.02),
    }


def reference(x_prompt, x_sample, norm_mix, w_in, conv_w, conv_b, w_rg, b_rg, w_ig, b_ig,
              lru_lambda, lambda_q1, lambda_k1, lambda_q2, lambda_k2, subln_g, w_out,
              norm_ffn, w_gate, w_up, w_down, norm_final):
    y_prompt = run_trunk(x_prompt, norm_mix, w_in, conv_w, conv_b, w_rg, b_rg, w_ig, b_ig,
                         lru_lambda, lambda_q1, lambda_k1, lambda_q2, lambda_k2, subln_g,
                         w_out, norm_ffn, w_gate, w_up, w_down, norm_final)
    y_sample = run_trunk(x_sample, norm_mix, w_in, conv_w, conv_b, w_rg, b_rg, w_ig, b_ig,
                         lru_lambda, lambda_q1, lambda_k1, lambda_q2, lambda_k2, subln_g,
                         w_out, norm_ffn, w_gate, w_up, w_down, norm_final)
    return (y_prompt, y_sample)
```

```cpp
#include <hip/hip_runtime.h>
#include <hip/hip_cooperative_groups.h>
#include <cstdio>
#include <cstdint>
namespace cg = cooperative_groups;

#define LAS __attribute__((address_space(3)))
typedef unsigned short bf16_t;
typedef short bf16x8 __attribute__((ext_vector_type(8)));
typedef short s16x4 __attribute__((ext_vector_type(4)));
typedef float f32x2 __attribute__((ext_vector_type(2)));
typedef float f32x4 __attribute__((ext_vector_type(4)));
typedef float f32x16 __attribute__((ext_vector_type(16)));
typedef unsigned u32x2 __attribute__((ext_vector_type(2)));
typedef unsigned u32x4 __attribute__((ext_vector_type(4)));

constexpr int DM = 1024, MTOK = 65536, NPROJ = 2560, DFF = 2816, NGU = 2 * DFF;
constexpr int PROMPT_ROWS = 32768, S_P = 2048, S_S = 4096;
constexpr int COL_Q = 0, COL_G = 512, COL_K = 1024, COL_V = 1536, COL_XR = 2048;
constexpr float EPS = 1e-6f;
constexpr float LOG2E = 1.4426950408889634f;
constexpr float QSCALE = 0.125f * LOG2E;
constexpr int NWAVES = 8, NTHREADS = 512;

constexpr size_t MiB = 1u << 20;
constexpr size_t WS_CTL = 0, CTL_BYTES = 65536;
constexpr size_t WS_WIN = 1 * MiB, WS_WOUT = 6 * MiB, WS_WGU = 8 * MiB, WS_WDN = 19 * MiB;
constexpr size_t WS_SSQ = 25 * MiB;
constexpr size_t WS_XN = 32 * MiB;
constexpr size_t WS_HF = 32 * MiB;
constexpr size_t WS_STASH = 96 * MiB;
constexpr size_t WS_PROJ = 160 * MiB;
constexpr size_t WS_H = 160 * MiB;
constexpr size_t WS_END = 512 * MiB;

constexpr int LDS_BYTES = 147456;

__device__ __forceinline__ unsigned cvt_pk_bf16(float lo, float hi) { unsigned r; asm volatile("v_cvt_pk_bf16_f32 %0, %1, %2" : "=v"(r) : "v"(lo), "v"(hi)); return r; }
__device__ __forceinline__ float bf16lo(unsigned u) { return __uint_as_float(u << 16); }
__device__ __forceinline__ float bf16hi(unsigned u) { return __uint_as_float(u & 0xffff0000u); }
__device__ __forceinline__ float wave_sum(float v) {
#pragma unroll
    for (int o = 1; o < 64; o <<= 1) v += __shfl_xor(v, o);
    return v;
}
__device__ __forceinline__ float fast_sigmoid(float x) { return __builtin_amdgcn_rcpf(1.0f + __builtin_amdgcn_exp2f(-LOG2E * x)); }

namespace pg8 {
constexpr int BM = 256, BK = 64, HALF = 128, HTB = HALF * BK * 2, STAGE_BYTES = 8 * HTB, NXCD = 8, WGM = 8;
__host__ __device__ __forceinline__ int lds_byte(int r, int c) { const int st = (r >> 4) * 2 + (c >> 5), rr = r & 15, cc = c & 31, ob = rr * 64 + cc * 2; return st * 1024 + (ob ^ (((ob >> 9) & 1) << 5)); }
__host__ __device__ __forceinline__ void stage_rc(int b, int& R, int& C) { const int st = b / 1024, sb = b % 1024, swz = sb ^ (((sb >> 9) & 1) << 5); R = (st >> 1) * 16 + swz / 64; C = (st & 1) * 32 + (swz % 64) / 2; }
__host__ __device__ __forceinline__ int perm32(int rho) { const int n = rho >> 4, i = rho & 15; return 8 * (i >> 2) + 4 * n + (i & 3); }

struct Unit { int pm, pn; };
struct Gemm { const bf16_t* A; const bf16_t* Bt; int lda; int M, N, K; };

struct StaticOrder {
    int nM, nN, nwg, G, c;
    __device__ void init(int M, int N, int G_, int c_) { nM = M / BM; nN = N / BM; nwg = nM * nN; G = G_; c = c_; }
    __device__ bool next(int i, Unit& u) const {
        const long L = (long)i * G + c; if (L >= nwg) return false;
        int wgid = (int)L; { const int q = nwg / NXCD, r = nwg % NXCD, xcd = wgid % NXCD, off = wgid / NXCD; wgid = (xcd < r ? xcd * (q + 1) : r * (q + 1) + (xcd - r) * q) + off; }
        const int nig = WGM * nN, gid = wgid / nig, fm = gid * WGM, gsz = (nM - fm) < WGM ? (nM - fm) : WGM;
        u.pm = fm + ((wgid % nig) % gsz); u.pn = (wgid % nig) / gsz; return true;
    }
};


struct EpiStoreBf16 {
    bf16_t* O; int ldc;
    __device__ __forceinline__ void operator()(const f32x4 (&acc)[2][2][4][2], const Unit& u, int wr, int wc, int fr, int fq) const {
        const int row0 = u.pm * BM + wr * 64 + fr, col0 = u.pn * BM + wc * 32 + 8 * fq;
#pragma unroll
        for (int ai = 0; ai < 2; ++ai)
#pragma unroll
            for (int m = 0; m < 4; ++m) { bf16_t* rowp = O + (size_t)(row0 + ai * HALF + m * 16) * ldc + col0;
#pragma unroll
                for (int bj = 0; bj < 2; ++bj) { const f32x4 v0 = acc[ai][bj][m][0], v1 = acc[ai][bj][m][1];
                    u32x4 w; w.x = cvt_pk_bf16(v0[0], v0[1]); w.y = cvt_pk_bf16(v0[2], v0[3]); w.z = cvt_pk_bf16(v1[0], v1[1]); w.w = cvt_pk_bf16(v1[2], v1[3]);
                    *(u32x4*)(rowp + bj * HALF) = w; } }
    }
};
template <bool WRITE_BF16> struct EpiResid {
    const float* r0; const float* r1;
    float* out; bf16_t* xn; float* ssq;
    __device__ __forceinline__ void operator()(const f32x4 (&acc)[2][2][4][2], const Unit& u, int wr, int wc, int fr, int fq) const {
        const int row0 = u.pm * BM + wr * 64 + fr, col0 = u.pn * BM + wc * 32 + 8 * fq;
        const float* rbase = (row0 < PROMPT_ROWS) ? r0 : (r1 - (size_t)PROMPT_ROWS * DM);
#pragma unroll
        for (int ai = 0; ai < 2; ++ai)
#pragma unroll
            for (int m = 0; m < 4; ++m) { const int row = row0 + ai * HALF + m * 16; const float* rp = rbase + (size_t)row * DM + col0; float* op = out + (size_t)row * DM + col0;
                float ss = 0.f;
#pragma unroll
                for (int bj = 0; bj < 2; ++bj) { const f32x4 a0 = *(const f32x4*)(rp + bj * HALF), a1 = *(const f32x4*)(rp + bj * HALF + 4);
                    const f32x4 v0 = acc[ai][bj][m][0] + a0, v1 = acc[ai][bj][m][1] + a1;
                    ss += (v0[0] * v0[0] + v0[1] * v0[1]) + (v0[2] * v0[2] + v0[3] * v0[3]); ss += (v1[0] * v1[0] + v1[1] * v1[1]) + (v1[2] * v1[2] + v1[3] * v1[3]);
                    *(f32x4*)(op + bj * HALF) = v0; *(f32x4*)(op + bj * HALF + 4) = v1;
                    if (WRITE_BF16) { u32x4 w; w.x = cvt_pk_bf16(v0[0], v0[1]); w.y = cvt_pk_bf16(v0[2], v0[3]); w.z = cvt_pk_bf16(v1[0], v1[1]); w.w = cvt_pk_bf16(v1[2], v1[3]);
                        *(u32x4*)(xn + (size_t)row * DM + col0 + bj * HALF) = w; } }
                ss += __shfl_xor(ss, 16); ss += __shfl_xor(ss, 32);
                if (fq == 0) ssq[(size_t)row * 16 + u.pn * 4 + wc] = ss; }
    }
};
struct EpiSwiGLU {
    const float* ssq; bf16_t* H;
    __device__ __forceinline__ void operator()(const f32x4 (&acc)[2][2][4][2], const Unit& u, int wr, int wc, int fr, int fq) const {
        const int row0 = u.pm * BM + wr * 64 + fr, col0 = u.pn * HALF + wc * 32 + 8 * fq;
#pragma unroll
        for (int ai = 0; ai < 2; ++ai)
#pragma unroll
            for (int m = 0; m < 4; ++m) { const int row = row0 + ai * HALF + m * 16;
                const f32x4* sp = (const f32x4*)(ssq + (size_t)row * 16); const f32x4 s0 = sp[0], s1 = sp[1], s2 = sp[2], s3 = sp[3];
                const f32x4 st = (s0 + s1) + (s2 + s3); const float tot = (st[0] + st[1]) + (st[2] + st[3]);
                const float rstd = __builtin_amdgcn_rsqf(tot * (1.0f / DM) + EPS);
                float o[8];
#pragma unroll
                for (int n = 0; n < 2; ++n)
#pragma unroll
                    for (int e = 0; e < 4; ++e) { const float g = acc[ai][0][m][n][e] * rstd, up = acc[ai][1][m][n][e] * rstd; o[n * 4 + e] = g * up * fast_sigmoid(g); }
                u32x4 w; w.x = cvt_pk_bf16(o[0], o[1]); w.y = cvt_pk_bf16(o[2], o[3]); w.z = cvt_pk_bf16(o[4], o[5]); w.w = cvt_pk_bf16(o[6], o[7]);
                *(u32x4*)(H + (size_t)row * DFF + col0) = w; }
    }
};

template <class Epi>
__device__ __forceinline__ void gemm_phase(LAS unsigned char* lds, const Gemm g, const StaticOrder& S, const Epi& E) {
    int tid = threadIdx.x; asm volatile("" : "+v"(tid));
    const int wid = __builtin_amdgcn_readfirstlane(tid >> 6), lane = tid & 63, wr = wid >> 2, wc = wid & 3, fr = lane & 15, fq = lane >> 4;
    const int K = g.K, nt = K / BK, lda = g.lda;
    unsigned voffA[2], voffB[2];
#pragma unroll
    for (int i = 0; i < 2; ++i) { int R, C; stage_rc(tid * 16 + i * 8192, R, C); const int Rb = (R & ~31) + perm32(R & 31);
        voffA[i] = (unsigned)(R * lda + C) * 2u; voffB[i] = (unsigned)(Rb * K + C) * 2u; }
    const size_t kstep = (size_t)(BK * 2);
    const size_t hstepA = (size_t)HALF * lda * 2, hstepB = (size_t)HALF * K * 2;
    const size_t tstepA = 2 * hstepA, tstepB = 2 * hstepB;
    const unsigned ldsw = (unsigned)wid * 1024u;
    const int aoff = lds_byte(wr * 64 + fr, fq * 8), boff = lds_byte(wc * 32 + fr, fq * 8);
#define PG8_SA(b, h) (((b) * 2 + (h)) * HTB)
#define PG8_SB(b, h) ((4 + (b) * 2 + (h)) * HTB)
#define PG8_STAGE(bufoff, gbase, voff) do { _Pragma("unroll") for (int _i = 0; _i < 2; ++_i) \
        __builtin_amdgcn_global_load_lds((const unsigned*)((const char*)(gbase) + (voff)[_i]), (LAS unsigned*)(lds + (bufoff) + ldsw + _i * 8192), 16, 0, 0); } while (0)
#define PG8_LDA(dst, b, h) do { _Pragma("unroll") for (int m = 0; m < 4; ++m) _Pragma("unroll") for (int k = 0; k < 2; ++k) dst[m][k] = *(const LAS bf16x8*)(lds + PG8_SA(b, h) + aoff + m * 2048 + k * 1024); } while (0)
#define PG8_LDB(dst, b, h) do { _Pragma("unroll") for (int n = 0; n < 2; ++n) _Pragma("unroll") for (int k = 0; k < 2; ++k) dst[n][k] = *(const LAS bf16x8*)(lds + PG8_SB(b, h) + boff + n * 2048 + k * 1024); } while (0)
#define PG8_MMA(ai, bj, At, Bt) do { __builtin_amdgcn_s_setprio(1); _Pragma("unroll") for (int m = 0; m < 4; ++m) _Pragma("unroll") for (int n = 0; n < 2; ++n) _Pragma("unroll") for (int k = 0; k < 2; ++k) \
        acc[ai][bj][m][n] = __builtin_amdgcn_mfma_f32_16x16x32_bf16(Bt[n][k], At[m][k], acc[ai][bj][m][n], 0, 0, 0); __builtin_amdgcn_s_setprio(0); } while (0)
#define PG8_WAIT_V(n) asm volatile("s_waitcnt vmcnt(" #n ")" ::: "memory")
#define PG8_WAIT_L(n) asm volatile("s_waitcnt lgkmcnt(" #n ")" ::: "memory")
#define PG8_BAR __builtin_amdgcn_s_barrier()
#define PG8_SCHED __builtin_amdgcn_sched_barrier(0)
    Unit cur, nxt; int ui = 0;
    if (!S.next(0, cur)) return;
    f32x4 acc[2][2][4][2];
#pragma unroll
    for (int a = 0; a < 2; ++a)
#pragma unroll
        for (int b = 0; b < 2; ++b)
#pragma unroll
            for (int m = 0; m < 4; ++m)
#pragma unroll
                for (int n = 0; n < 2; ++n) acc[a][b][m][n] = (f32x4){0.f, 0.f, 0.f, 0.f};
    bf16x8 At[4][2], B0[2][2], B1[2][2];
    const char* cA = (const char*)g.A + (size_t)cur.pm * tstepA; const char* cB = (const char*)g.Bt + (size_t)cur.pn * tstepB;
    PG8_STAGE(PG8_SB(0, 0), cB, voffB); PG8_STAGE(PG8_SB(0, 1), cB + hstepB, voffB); PG8_STAGE(PG8_SA(0, 0), cA, voffA); PG8_STAGE(PG8_SA(0, 1), cA + hstepA, voffA);
    if (wr == 1) PG8_BAR;
    PG8_WAIT_V(2); PG8_BAR;
    PG8_STAGE(PG8_SB(1, 0), cB + kstep, voffB); PG8_STAGE(PG8_SA(1, 0), cA + kstep, voffA); PG8_STAGE(PG8_SB(1, 1), cB + hstepB + kstep, voffB);
    PG8_WAIT_V(6); PG8_BAR;
    for (;;) {
        const bool has_next = S.next(ui + 1, nxt);
        const char* nA = has_next ? (const char*)g.A + (size_t)nxt.pm * tstepA : cA; const char* nB = has_next ? (const char*)g.Bt + (size_t)nxt.pn * tstepB : cB;
        for (int t = 0; t < nt; t += 2) {
            const bool last = (t == nt - 2);
            const char* a1 = cA + (size_t)(t + 1) * kstep;
            const char* a2 = last ? nA : cA + (size_t)(t + 2) * kstep; const char* b2 = last ? nB : cB + (size_t)(t + 2) * kstep;
            const char* a3 = a2 + kstep; const char* b3 = b2 + kstep;
            PG8_LDB(B0, 0, 0); PG8_LDB(B1, 0, 1); PG8_SCHED; PG8_LDA(At, 0, 0); PG8_STAGE(PG8_SA(1, 1), a1 + hstepA, voffA);
            PG8_WAIT_V(8); PG8_WAIT_L(0); PG8_BAR; PG8_MMA(0, 0, At, B0); PG8_MMA(0, 1, At, B1); PG8_BAR; PG8_SCHED;
            PG8_LDA(At, 0, 1); PG8_STAGE(PG8_SB(0, 0), b2, voffB); PG8_STAGE(PG8_SB(0, 1), b2 + hstepB, voffB); PG8_STAGE(PG8_SA(0, 0), a2, voffA);
            PG8_WAIT_V(8); PG8_WAIT_L(0); PG8_BAR; PG8_MMA(1, 0, At, B0); PG8_MMA(1, 1, At, B1); PG8_BAR; PG8_SCHED;
            PG8_LDB(B0, 1, 0); PG8_LDB(B1, 1, 1); PG8_SCHED; PG8_LDA(At, 1, 0); PG8_STAGE(PG8_SA(0, 1), a2 + hstepA, voffA);
            PG8_WAIT_V(8); PG8_WAIT_L(0); PG8_BAR; PG8_MMA(0, 0, At, B0); PG8_MMA(0, 1, At, B1); PG8_BAR; PG8_SCHED;
            PG8_LDA(At, 1, 1); PG8_STAGE(PG8_SB(1, 0), b3, voffB); PG8_STAGE(PG8_SB(1, 1), b3 + hstepB, voffB); PG8_STAGE(PG8_SA(1, 0), a3, voffA);
            PG8_WAIT_V(8); PG8_WAIT_L(0); PG8_BAR; PG8_MMA(1, 0, At, B0); PG8_MMA(1, 1, At, B1); PG8_BAR; PG8_SCHED;
        }
        if (wr == 0) PG8_BAR;
        E(acc, cur, wr, wc, fr, fq);
        if (!has_next) break;
#pragma unroll
        for (int a = 0; a < 2; ++a)
#pragma unroll
            for (int b = 0; b < 2; ++b)
#pragma unroll
                for (int m = 0; m < 4; ++m)
#pragma unroll
                    for (int n = 0; n < 2; ++n) acc[a][b][m][n] = (f32x4){0.f, 0.f, 0.f, 0.f};
        cur = nxt; cA = nA; cB = nB; ++ui;
        if (wr == 1) PG8_BAR;
    }
    PG8_WAIT_V(0);
    PG8_BAR;
#undef PG8_SA
#undef PG8_SB
#undef PG8_STAGE
#undef PG8_LDA
#undef PG8_LDB
#undef PG8_MMA
#undef PG8_WAIT_V
#undef PG8_WAIT_L
#undef PG8_BAR
#undef PG8_SCHED
}
}

namespace att {
constexpr int PITCH = NPROJ, QBLK = 32, KVBLK = 64;
constexpr int SHM_V = KVBLK * 128 * 2, SHM_K = KVBLK * 64 * 2, OFF_K = 2 * SHM_V, OFF_WS = OFF_K + 2 * SHM_K;
constexpr float THR = 8.f;
#define KSWZ64(row, cb) ((row) * 128 + ((cb) ^ ((((row) >> 1) & 7) << 4)))
#define SBAR() __builtin_amdgcn_sched_barrier(0)
__device__ __forceinline__ int crow(int r, int hi) { return (r & 3) + 8 * (r >> 2) + 4 * hi; }

__device__ __forceinline__ void partialSM(f32x16& p0, f32x16& p1, float& m_reg, float& alpha, float mp, float dj0) {
#pragma unroll
    for (int r = 0; r < 16; ++r) { const float c = (float)((r & 3) + 8 * (r >> 2));
        p0[r] = __builtin_fmaf(-mp, __builtin_fabsf(dj0 + c), p0[r]); p1[r] = __builtin_fmaf(-mp, __builtin_fabsf(dj0 + (c + 32.f)), p1[r]); }
    float pmax = p0[0];
#pragma unroll
    for (int r = 1; r < 16; ++r) pmax = fmaxf(pmax, p0[r]);
#pragma unroll
    for (int r = 0; r < 16; ++r) pmax = fmaxf(pmax, p1[r]);
    { auto rr = __builtin_amdgcn_permlane32_swap(__float_as_uint(pmax), __float_as_uint(pmax), false, false);
      pmax = fmaxf(__uint_as_float(rr[0]), __uint_as_float(rr[1])); }
    float mn;
    if (__builtin_expect(__all(pmax - m_reg <= THR), 1)) { mn = m_reg; alpha = 1.f; }
    else { mn = fmaxf(m_reg, pmax); alpha = __builtin_amdgcn_exp2f(m_reg - mn); m_reg = mn; }
#pragma unroll
    for (int r = 0; r < 16; ++r) { p0[r] -= mn; p1[r] -= mn; }
#pragma unroll
    for (int r = 0; r < 16; ++r) p0[r] = __builtin_amdgcn_exp2f(p0[r]);
}
__device__ __forceinline__ void finishSM(f32x16& p0, f32x16& p1, float alpha, float& l_reg, bf16x8& pa0, bf16x8& pa1, bf16x8& pa2, bf16x8& pa3) {
#pragma unroll
    for (int r = 0; r < 16; ++r) p1[r] = __builtin_amdgcn_exp2f(p1[r]);
    float ps = 0;
#pragma unroll
    for (int r = 0; r < 16; ++r) ps += p0[r];
#pragma unroll
    for (int r = 0; r < 16; ++r) ps += p1[r];
    { auto rr = __builtin_amdgcn_permlane32_swap(__float_as_uint(ps), __float_as_uint(ps), false, false);
      ps = __uint_as_float(rr[0]) + __uint_as_float(rr[1]); }
    l_reg = l_reg * alpha + ps;
#define PK4(P, BASE, OUT) do { unsigned a0 = cvt_pk_bf16(P[BASE + 0], P[BASE + 1]), a1 = cvt_pk_bf16(P[BASE + 2], P[BASE + 3]);   \
    unsigned b0 = cvt_pk_bf16(P[BASE + 4], P[BASE + 5]), b1 = cvt_pk_bf16(P[BASE + 6], P[BASE + 7]);                              \
    auto r0 = __builtin_amdgcn_permlane32_swap(a0, b0, false, false); auto r1 = __builtin_amdgcn_permlane32_swap(a1, b1, false, false); \
    u32x4 w = {r0[0], r1[0], r0[1], r1[1]}; OUT = *reinterpret_cast<bf16x8*>(&w); } while (0)
    PK4(p0, 0, pa0); PK4(p0, 8, pa1); PK4(p1, 0, pa2); PK4(p1, 8, pa3);
#undef PK4
}
__device__ __forceinline__ void qkt(f32x16& p0, f32x16& p1, const char* Ks, const bf16x8* qr, int r32, int hi) {
    p0 = f32x16{}; p1 = f32x16{};
#pragma unroll
    for (int d0 = 0; d0 < 4; ++d0) { const int cb = d0 * 32 + hi * 16;
        const bf16x8 b0 = *reinterpret_cast<const bf16x8*>(Ks + KSWZ64(r32, cb));
        const bf16x8 b1 = *reinterpret_cast<const bf16x8*>(Ks + KSWZ64(32 + r32, cb));
        p0 = __builtin_amdgcn_mfma_f32_32x32x16_bf16(b0, qr[d0], p0, 0, 0, 0);
        p1 = __builtin_amdgcn_mfma_f32_32x32x16_bf16(b1, qr[d0], p1, 0, 0, 0); }
}
__device__ __forceinline__ int v_st(int k, int c) { const int kk = (k & ~0xC) | ((k & 4) << 1) | ((k & 8) >> 1); return ((kk >> 3) * 4 + (c >> 5)) * 512 + ((kk & 7) * 32 + (c & 31)) * 2; }
__device__ __forceinline__ int v_rd_base(int lane) { return ((lane & 3) << 3) | (((lane >> 2) & 3) << 6) | (((lane >> 4) & 1) << 5) | (((lane >> 5) & 1) << 8); }
constexpr int v_rd_off(int d0, int ks, int half) { return d0 * 512 + ks * 4096 + half * 2048; }
template <int OFF> __device__ __forceinline__ s16x4 tr_read(int vb) {
    s16x4 r; asm volatile("ds_read_b64_tr_b16 %0, %1 offset:%2" : "=&v"(r) : "v"(vb), "i"(OFF) : "memory"); return r;
}
template <int D0> __device__ __forceinline__ void pv_one(f32x16& od, int vb, bf16x8 pa0, bf16x8 pa1, bf16x8 pa2, bf16x8 pa3) {
    const s16x4 l0 = tr_read<v_rd_off(D0, 0, 0)>(vb), h0 = tr_read<v_rd_off(D0, 0, 1)>(vb), l1 = tr_read<v_rd_off(D0, 1, 0)>(vb), h1 = tr_read<v_rd_off(D0, 1, 1)>(vb);
    const s16x4 l2 = tr_read<v_rd_off(D0, 2, 0)>(vb), h2 = tr_read<v_rd_off(D0, 2, 1)>(vb), l3 = tr_read<v_rd_off(D0, 3, 0)>(vb), h3 = tr_read<v_rd_off(D0, 3, 1)>(vb);
    asm volatile("s_waitcnt lgkmcnt(0)" ::: "memory"); SBAR();
#define PK(L, H) (bf16x8){L[0], L[1], L[2], L[3], H[0], H[1], H[2], H[3]}
    od = __builtin_amdgcn_mfma_f32_32x32x16_bf16(pa0, PK(l0, h0), od, 0, 0, 0);
    od = __builtin_amdgcn_mfma_f32_32x32x16_bf16(pa1, PK(l1, h1), od, 0, 0, 0);
    od = __builtin_amdgcn_mfma_f32_32x32x16_bf16(pa2, PK(l2, h2), od, 0, 0, 0);
    od = __builtin_amdgcn_mfma_f32_32x32x16_bf16(pa3, PK(l3, h3), od, 0, 0, 0);
#undef PK
}
__device__ __forceinline__ void pv_d0(f32x16* o, int vb, bf16x8 pa0, bf16x8 pa1, bf16x8 pa2, bf16x8 pa3) {
    pv_one<0>(o[0], vb, pa0, pa1, pa2, pa3); pv_one<1>(o[1], vb, pa0, pa1, pa2, pa3); pv_one<2>(o[2], vb, pa0, pa1, pa2, pa3); pv_one<3>(o[3], vb, pa0, pa1, pa2, pa3);
}

template <int PASS>
__device__ __forceinline__ void attn_pass(const bf16_t* __restrict__ Qb, const bf16_t* __restrict__ Kh, const bf16_t* __restrict__ Vh, int NT, int t0, int ipos0, float mp,
                                          float lam, const float* __restrict__ subg, float* stash, bf16_t* Ob, char* lds) {
    int tid = threadIdx.x; asm volatile("" : "+v"(tid));
    const int wid = tid >> 6, lane = tid & 63, r32 = lane & 31, hi = lane >> 5;
    char* V_lds = lds; char* K_lds = lds + OFF_K;
    float* ws = (float*)(lds + OFF_WS) + wid * 64; float* li_l = ws; float* al_l = ws + 32;
    float m_reg = -1e30f, l_reg = 0; f32x16 o[4] = {}; bf16x8 qr[4];
    const bf16_t* Qw = Qb + (long)(wid * QBLK + r32) * PITCH + hi * 8;
#pragma unroll
    for (int d0 = 0; d0 < 4; ++d0) qr[d0] = *reinterpret_cast<const bf16x8*>(Qw + d0 * 16);
    const int sr = tid >> 4, sc = (tid & 15) * 8, vst0 = v_st(sr, sc), vst1 = v_st(32 + sr, sc);
    const int kr = tid >> 3, kc = (tid & 7) * 8, kst = KSWZ64(kr, kc * 2);
    const int vb0 = (int)(uintptr_t)V_lds + v_rd_base(lane);
    const int ipos = ipos0 + wid * QBLK + r32;
    struct { bf16x8 vs0, vs1, ks0; } sr_[2];
#define TJ(j) ((t0 + (j)) & (NT - 1))
#define DJ0(j) ((float)(TJ(j) * KVBLK + 4 * hi - ipos))
#define SLOAD(i, j) do { const long k0_ = (long)TJ(j) * KVBLK; sr_[i].vs0 = *reinterpret_cast<const bf16x8*>(&Vh[(k0_ + sr) * PITCH + sc]); \
    sr_[i].vs1 = *reinterpret_cast<const bf16x8*>(&Vh[(k0_ + 32 + sr) * PITCH + sc]); sr_[i].ks0 = *reinterpret_cast<const bf16x8*>(&Kh[(k0_ + kr) * PITCH + kc]); } while (0)
#define SWRITE(b, i) do { *(bf16x8*)(V_lds + (b) * SHM_V + vst0) = sr_[i].vs0; *(bf16x8*)(V_lds + (b) * SHM_V + vst1) = sr_[i].vs1; \
    *(bf16x8*)(K_lds + (b) * SHM_K + kst) = sr_[i].ks0; } while (0)
#define SWAIT() asm volatile("s_waitcnt vmcnt(3)" ::: "memory")
#define RESC(a) do { if (__any((a) < 1.f)) { if (hi == 0) al_l[r32] = (a); asm volatile("s_waitcnt lgkmcnt(0)" ::: "memory"); \
    _Pragma("unroll") for (int d = 0; d < 4; ++d) _Pragma("unroll") for (int r = 0; r < 16; ++r) o[d][r] *= al_l[crow(r, hi)]; } } while (0)
    f32x16 pA0, pA1, pB0, pB1; float alA, alB; bf16x8 pa0, pa1, pa2, pa3;
    constexpr int SE = 0, SO = 1;
    SLOAD(SE, 0); asm volatile("s_waitcnt vmcnt(0)" ::: "memory"); SWRITE(0, SE); __syncthreads();
    qkt(pA0, pA1, K_lds, qr, r32, hi); partialSM(pA0, pA1, m_reg, alA, mp, DJ0(0));
    SLOAD(SO, 1); if (2 < NT) SLOAD(SE, 2);
    SWAIT(); SWRITE(1, SO); __syncthreads();
    for (int j = 1; j + 1 < NT; j += 2) {
        SBAR(); qkt(pB0, pB1, K_lds + SHM_K, qr, r32, hi);
        finishSM(pA0, pA1, alA, l_reg, pa0, pa1, pa2, pa3); SBAR();
        SLOAD(SO, j + 2); SBAR();
        pv_d0(o, vb0, pa0, pa1, pa2, pa3); partialSM(pB0, pB1, m_reg, alB, mp, DJ0(j));
        __syncthreads(); SWAIT(); SWRITE(0, SE);
        RESC(alB); __syncthreads();
        SBAR(); qkt(pA0, pA1, K_lds, qr, r32, hi);
        finishSM(pB0, pB1, alB, l_reg, pa0, pa1, pa2, pa3); SBAR();
        if (j + 3 < NT) SLOAD(SE, j + 3); SBAR();
        pv_d0(o, vb0 + SHM_V, pa0, pa1, pa2, pa3); partialSM(pA0, pA1, m_reg, alA, mp, DJ0(j + 1));
        __syncthreads(); SWAIT(); SWRITE(1, SO);
        RESC(alA); __syncthreads();
    }
    SBAR(); qkt(pB0, pB1, K_lds + SHM_K, qr, r32, hi);
    finishSM(pA0, pA1, alA, l_reg, pa0, pa1, pa2, pa3); SBAR();
    pv_d0(o, vb0, pa0, pa1, pa2, pa3); partialSM(pB0, pB1, m_reg, alB, mp, DJ0(NT - 1));
    __syncthreads(); RESC(alB);
    finishSM(pB0, pB1, alB, l_reg, pa0, pa1, pa2, pa3); SBAR();
    pv_d0(o, vb0 + SHM_V, pa0, pa1, pa2, pa3);
    if (hi == 0) li_l[r32] = l_reg; asm volatile("s_waitcnt lgkmcnt(0)" ::: "memory");
    float rli[16];
#pragma unroll
    for (int r = 0; r < 16; ++r) rli[r] = __builtin_amdgcn_rcpf(li_l[crow(r, hi)]);
    float* st = stash + (long)(wid * QBLK) * 128 + r32;
    if (PASS == 0) {
#pragma unroll
        for (int r = 0; r < 16; ++r) { const int orow = crow(r, hi);
#pragma unroll
            for (int d0 = 0; d0 < 4; ++d0) st[orow * 128 + d0 * 32] = o[d0][r] * rli[r]; }
    } else {
        float g8[4];
#pragma unroll
        for (int d0 = 0; d0 < 4; ++d0) g8[d0] = 0.8f * subg[d0 * 32 + r32];
        bf16_t* Ow = Ob + (long)(wid * QBLK) * PITCH + r32;
#pragma unroll
        for (int r = 0; r < 16; ++r) { const int orow = crow(r, hi); float ss = 0.f;
#pragma unroll
            for (int d0 = 0; d0 < 4; ++d0) { const float dl = st[orow * 128 + d0 * 32] - lam * (o[d0][r] * rli[r]); o[d0][r] = dl; ss += dl * dl; }
            ss += __shfl_xor(ss, 1); ss += __shfl_xor(ss, 2); ss += __shfl_xor(ss, 4); ss += __shfl_xor(ss, 8); ss += __shfl_xor(ss, 16);
            const float rn = __builtin_amdgcn_rsqf(ss * (1.0f / 128.0f) + EPS);
#pragma unroll
            for (int d0 = 0; d0 < 4; ++d0) Ow[(long)orow * PITCH + d0 * 32] = (bf16_t)(cvt_pk_bf16(o[d0][r] * rn * g8[d0], 0.f) & 0xffffu); }
    }
    asm volatile("s_waitcnt vmcnt(0) lgkmcnt(0)" ::: "memory");
    __syncthreads();
#undef TJ
#undef DJ0
#undef SLOAD
#undef SWRITE
#undef SWAIT
#undef RESC
}
}

namespace lru {
constexpr int T = 128, PITCH = NPROJ;
constexpr int OFF_XC = 0, OFF_G = 16384, OFF_CAR = OFF_G + T * 128 * 4, OFF_CIN = OFF_CAR + 16 * 64 * 8;
__device__ __forceinline__ int crow(int r, int hi) { return (r & 3) + 8 * (r >> 2) + 4 * hi; }
__device__ __forceinline__ float gelu_tanh(float x) { const float u = 0.7978845608028654f * (x + 0.044715f * x * x * x); return x * fast_sigmoid(2.0f * u); }

template <int DIR>
__device__ __forceinline__ void lru_dir(bf16_t* proj, bf16_t* hf, long R0, int S, int n, const float* __restrict__ conv_w, const float* __restrict__ conv_b,
                                        const float* __restrict__ w_rg, const float* __restrict__ b_rg, const float* __restrict__ w_ig, const float* __restrict__ b_ig,
                                        const float* __restrict__ lam, char* lds) {
    int tid = threadIdx.x; asm volatile("" : "+v"(tid));
    const int wid = tid >> 6, lane = tid & 63, r32 = lane & 31, hi = lane >> 5;
    const int cp = tid & 31, tsub = tid >> 5, c0 = 2 * cp;
    float* G = (float*)(lds + OFF_G); f32x2* CAR = (f32x2*)(lds + OFF_CAR); float* CIN = (float*)(lds + OFF_CIN);
    float cw[4][2], cb[2], k1[2];
#pragma unroll
    for (int e = 0; e < 2; ++e) { const int ch = n * 64 + c0 + e;
#pragma unroll
        for (int j = 0; j < 4; ++j) cw[j][e] = conv_w[j * 512 + ch];
        cb[e] = conv_b[ch];
        const float sp = log1pf(expf(-lam[DIR * 512 + ch]));
        k1[e] = -8.0f * sp * LOG2E; }
    const int ct = wid & 3, gtype = ct >> 1, dcol = (ct & 1) * 32 + r32;
    const float* Wg = (gtype ? w_ig : w_rg) + (size_t)(DIR * 8 + n) * 64 * 64;
    const float gbias = (gtype ? b_ig : b_rg)[DIR * 512 + n * 64 + dcol];
    bf16x8 bfr[4];
#pragma unroll
    for (int ks = 0; ks < 4; ++ks) { float wv[8];
#pragma unroll
        for (int j = 0; j < 8; ++j) wv[j] = Wg[(ks * 16 + 8 * hi + j) * 64 + dcol];
        u32x4 w; w.x = cvt_pk_bf16(wv[0], wv[1]); w.y = cvt_pk_bf16(wv[2], wv[3]); w.z = cvt_pk_bf16(wv[4], wv[5]); w.w = cvt_pk_bf16(wv[6], wv[7]);
        bfr[ks] = *reinterpret_cast<bf16x8*>(&w); }
    if (tid < 128) CIN[tid] = 0.f;
    __syncthreads();
    const int NC = S / T;
    for (int ci = 0; ci < NC; ++ci) {
        const int ck = DIR ? (NC - 1 - ci) : ci, t0 = ck * T, par = ci & 1;
        float xin[11][2];
#pragma unroll
        for (int k = 0; k < 11; ++k) { const int tb = t0 + 8 * tsub - 2 + k; unsigned v = 0u;
            if (tb >= 0 && tb < S) v = *(const unsigned*)(proj + (R0 + tb) * PITCH + COL_XR + n * 64 + c0);
            xin[k][0] = bf16lo(v); xin[k][1] = bf16hi(v); }
        float xc[8][2];
#pragma unroll
        for (int k = 0; k < 8; ++k)
#pragma unroll
            for (int e = 0; e < 2; ++e) xc[k][e] = cb[e] + cw[0][e] * xin[k][e] + cw[1][e] * xin[k + 1][e] + cw[2][e] * xin[k + 2][e] + cw[3][e] * xin[k + 3][e];
#pragma unroll
        for (int k = 0; k < 8; ++k) { const int tl = 8 * tsub + k;
            *(unsigned*)(lds + OFF_XC + tl * 128 + ((((c0 >> 3) ^ ((tl >> 1) & 7))) << 4) + (c0 & 7) * 2) = cvt_pk_bf16(xc[k][0], xc[k][1]); }
        __syncthreads();
#pragma unroll
        for (int rt2 = 0; rt2 < 2; ++rt2) { const int rt = (wid >> 2) * 2 + rt2; f32x16 acc = {};
#pragma unroll
            for (int ks = 0; ks < 4; ++ks) { const int row = rt * 32 + r32, cbb = ks * 32 + hi * 16;
                const bf16x8 a = *reinterpret_cast<const bf16x8*>(lds + OFF_XC + row * 128 + (cbb ^ (((row >> 1) & 7) << 4)));
                acc = __builtin_amdgcn_mfma_f32_32x32x16_bf16(a, bfr[ks], acc, 0, 0, 0); }
#pragma unroll
            for (int r = 0; r < 16; ++r) G[(rt * 32 + crow(r, hi)) * 128 + ct * 32 + r32] = fast_sigmoid(acc[r] + gbias); }
        __syncthreads();
        float av[8][2], bv[8][2];
#pragma unroll
        for (int k = 0; k < 8; ++k) { const int tl = 8 * tsub + k; const f32x2 rg = *(const f32x2*)&G[tl * 128 + c0], ig = *(const f32x2*)&G[tl * 128 + 64 + c0];
#pragma unroll
            for (int e = 0; e < 2; ++e) { const float l2a = rg[e] * k1[e]; av[k][e] = __builtin_amdgcn_exp2f(l2a);
                const float x = l2a * (2.0f * 0.6931471805599453f);
                float q = 1.0f + x * (1.0f / 6.0f); q = 1.0f + x * 0.2f * q; q = 1.0f + x * 0.25f * q; q = 1.0f + x * (1.0f / 3.0f) * q; q = 1.0f + x * 0.5f * q;
                const float m2 = fmaxf(-x * q, 1e-12f);
                bv[k][e] = __builtin_amdgcn_sqrtf(m2) * ig[e] * xc[k][e]; } }
        float A[2] = {1.f, 1.f}, Hh[2] = {0.f, 0.f};
#pragma unroll
        for (int kk = 0; kk < 8; ++kk) { const int k = DIR ? 7 - kk : kk;
#pragma unroll
            for (int e = 0; e < 2; ++e) { Hh[e] = av[k][e] * Hh[e] + bv[k][e]; A[e] *= av[k][e]; } }
        CAR[tsub * 64 + c0] = (f32x2){A[0], Hh[0]}; CAR[tsub * 64 + c0 + 1] = (f32x2){A[1], Hh[1]};
        __syncthreads();
        float h[2] = {CIN[par * 64 + c0], CIN[par * 64 + c0 + 1]};
        if (DIR == 0) { for (int s = 0; s < tsub; ++s) { const f32x2 q0 = CAR[s * 64 + c0], q1 = CAR[s * 64 + c0 + 1]; h[0] = q0[0] * h[0] + q0[1]; h[1] = q1[0] * h[1] + q1[1]; } }
        else { for (int s = 15; s > tsub; --s) { const f32x2 q0 = CAR[s * 64 + c0], q1 = CAR[s * 64 + c0 + 1]; h[0] = q0[0] * h[0] + q0[1]; h[1] = q1[0] * h[1] + q1[1]; } }
#pragma unroll
        for (int kk = 0; kk < 8; ++kk) { const int k = DIR ? 7 - kk : kk; const long row = R0 + t0 + 8 * tsub + k;
            h[0] = av[k][0] * h[0] + bv[k][0]; h[1] = av[k][1] * h[1] + bv[k][1];
            if (DIR == 0) { *(unsigned*)(hf + row * 512 + n * 64 + c0) = cvt_pk_bf16(h[0], h[1]); }
            else { const unsigned hv = *(const unsigned*)(hf + row * 512 + n * 64 + c0); unsigned* gp = (unsigned*)(proj + row * PITCH + COL_G + n * 64 + c0); const unsigned gv = *gp;
                const float y0 = (bf16lo(hv) + h[0]) * gelu_tanh(bf16lo(gv)), y1 = (bf16hi(hv) + h[1]) * gelu_tanh(bf16hi(gv));
                *gp = cvt_pk_bf16(y0, y1); } }
        if (tsub == (DIR ? 0 : 15)) { CIN[(par ^ 1) * 64 + c0] = h[0]; CIN[(par ^ 1) * 64 + c0 + 1] = h[1]; }
    }
    asm volatile("s_waitcnt vmcnt(0) lgkmcnt(0)" ::: "memory");
    __syncthreads();
}
}

#ifndef PH_MASK
#define PH_MASK 0x7f
#endif
struct Args { const float* in[22]; float* out; unsigned char* ws; };

__device__ __forceinline__ void transpose_item(const float* __restrict__ W, int K, int N, int k0, int n0, bf16_t* WT, int drow0, const float* __restrict__ ksc, float csc, LAS float* scr, int lane) {
#pragma unroll 8
    for (int i = 0; i < 32; ++i) { const int kk = 2 * i + (lane >> 5); const float s = (ksc ? ksc[k0 + kk] : 1.0f) * csc; scr[kk * 33 + (lane & 31)] = W[(size_t)(k0 + kk) * N + n0 + (lane & 31)] * s; }
    asm volatile("s_waitcnt lgkmcnt(0)" ::: "memory");
    const int c = lane & 7;
#pragma unroll
    for (int j = 0; j < 4; ++j) { const int n = (lane >> 3) + 8 * j; const LAS float* s = scr + (8 * c) * 33 + n;
        u32x4 o; o.x = cvt_pk_bf16(s[0 * 33], s[1 * 33]); o.y = cvt_pk_bf16(s[2 * 33], s[3 * 33]); o.z = cvt_pk_bf16(s[4 * 33], s[5 * 33]); o.w = cvt_pk_bf16(s[6 * 33], s[7 * 33]);
        *(u32x4*)(WT + (size_t)(drow0 + n) * K + k0 + 8 * c) = o; }
    asm volatile("s_waitcnt lgkmcnt(0)" ::: "memory");
}

__global__ void __launch_bounds__(NTHREADS, 2) mega_fwd(Args args) {
    extern __shared__ __attribute__((aligned(16))) unsigned char lds[];
    cg::grid_group grid = cg::this_grid();
    const int tid = threadIdx.x, lane = tid & 63, wave = __builtin_amdgcn_readfirstlane(tid >> 6);
    const int G = gridDim.x, bx = blockIdx.x;
    const int vcu = (G % 8 == 0) ? (bx % 8) * (G / 8) + bx / 8 : bx;
    unsigned char* ws = args.ws;
    const float* x_p = args.in[0]; const float* x_s = args.in[1];
    bf16_t* Win_t = (bf16_t*)(ws + WS_WIN); bf16_t* Wout_t = (bf16_t*)(ws + WS_WOUT); bf16_t* Wgu_t = (bf16_t*)(ws + WS_WGU); bf16_t* Wdn_t = (bf16_t*)(ws + WS_WDN);
    float* SSQ = (float*)(ws + WS_SSQ); bf16_t* XN = (bf16_t*)(ws + WS_XN); bf16_t* HF = (bf16_t*)(ws + WS_HF); float* STASH = (float*)(ws + WS_STASH);
    bf16_t* PROJ = (bf16_t*)(ws + WS_PROJ); bf16_t* HB = (bf16_t*)(ws + WS_H);
    float* out = args.out;
    const int gw = vcu * NWAVES + wave, NGW = G * NWAVES;

    if (PH_MASK & 1) {
        LAS float* scr = (LAS float*)((LAS unsigned char*)lds + wave * 16384);
        constexpr int I_IN = 16 * 80, I_OUT = 16 * 32, I_G = 16 * 88, I_U = 16 * 88, I_D = 44 * 32;
        constexpr int NITEMS = I_IN + I_OUT + I_G + I_U + I_D;
        for (int it = gw; it < NITEMS; it += NGW) {
            int r = it;
            if (r < I_IN) { const int kb = r / 80, nb = r % 80, n0 = nb * 32, reg = n0 >> 9, off = n0 & 511;
                const int dbase = reg == 0 ? COL_Q : reg == 1 ? COL_K : reg == 2 ? COL_V : reg == 3 ? COL_XR : COL_G;
                transpose_item(args.in[3], DM, NPROJ, kb * 64, n0, Win_t, dbase + off, nullptr, reg == 0 ? QSCALE : 1.0f, scr, lane); continue; } r -= I_IN;
            if (r < I_OUT) { const int kb = r / 32, nb = r % 32; transpose_item(args.in[16], DM, DM, kb * 64, nb * 32, Wout_t, nb * 32, nullptr, 1.0f, scr, lane); continue; } r -= I_OUT;
            if (r < I_G) { const int kb = r / 88, nb = r % 88, n0 = nb * 32; transpose_item(args.in[18], DM, DFF, kb * 64, n0, Wgu_t, 256 * (n0 >> 7) + (n0 & 127), args.in[17], 1.0f, scr, lane); continue; } r -= I_G;
            if (r < I_U) { const int kb = r / 88, nb = r % 88, n0 = nb * 32; transpose_item(args.in[19], DM, DFF, kb * 64, n0, Wgu_t, 256 * (n0 >> 7) + 128 + (n0 & 127), args.in[17], 1.0f, scr, lane); continue; } r -= I_U;
            { const int kb = r / 32, nb = r % 32; transpose_item(args.in[20], DFF, DM, kb * 64, nb * 32, Wdn_t, nb * 32, nullptr, 1.0f, scr, lane); }
        }
        const f32x4* g4 = (const f32x4*)args.in[2];
        for (int m = gw; m < MTOK; m += NGW) {
            const float* xrow = (m < PROMPT_ROWS) ? x_p + (size_t)m * DM : x_s + (size_t)(m - PROMPT_ROWS) * DM;
            const f32x4* xr = (const f32x4*)xrow + lane; f32x4 v[4]; float s = 0.f;
#pragma unroll
            for (int j = 0; j < 4; ++j) { v[j] = xr[64 * j]; s += (v[j].x * v[j].x + v[j].y * v[j].y) + (v[j].z * v[j].z + v[j].w * v[j].w); }
            const float rstd = __builtin_amdgcn_rsqf(wave_sum(s) * (1.0f / DM) + EPS);
            u32x2* o8 = (u32x2*)(XN + (size_t)m * DM) + lane;
#pragma unroll
            for (int j = 0; j < 4; ++j) { const f32x4 gg = g4[lane + 64 * j]; u32x2 w; w.x = cvt_pk_bf16(v[j].x * rstd * gg.x, v[j].y * rstd * gg.y); w.y = cvt_pk_bf16(v[j].z * rstd * gg.z, v[j].w * rstd * gg.w); o8[64 * j] = w; }
        }
    }
    grid.sync();

    if (PH_MASK & 2) { pg8::Gemm g{XN, Win_t, DM, MTOK, NPROJ, DM}; pg8::StaticOrder S; S.init(MTOK, NPROJ, G, bx);
      pg8::EpiStoreBf16 E{PROJ, NPROJ};
      pg8::gemm_phase(( LAS unsigned char*)lds, g, S, E); }
    grid.sync();

    if (PH_MASK & 4) {
        float lam;
        { float s1 = 0.f, s2 = 0.f;
          for (int i = 0; i < 64; ++i) { s1 += args.in[11][i] * args.in[12][i]; s2 += args.in[13][i] * args.in[14][i]; }
          lam = expf(s1) - expf(s2) + 0.2f; }
        float* stash = STASH + (size_t)bx * 256 * 128;
        constexpr int U_AS = 512, U_AP = 512, U_LS = 64, U_LP = 128, U_TOT = U_AS + U_AP + U_LS + U_LP;
        for (int u = vcu; u < U_TOT; u += G) {
            if (u < U_AS + U_AP) {
#ifndef NO_ATT
                int s, h, qb, S;
                if (u < U_AS) { const int pair = u >> 4; s = 16 + (pair >> 2); h = pair & 3; qb = u & 15; S = S_S; }
                else { const int u2 = u - U_AS, pair = u2 >> 3; s = pair >> 2; h = pair & 3; qb = u2 & 7; S = S_P; }
                const long R0 = (s < 16) ? (long)s * S_P : (long)PROMPT_ROWS + (long)(s - 16) * S_S;
                const float mp = exp2f(-2.0f * (float)(h + 1)) * LOG2E;
                bf16_t* base = PROJ + R0 * NPROJ;
                bf16_t* Qb = base + (long)(qb * 256) * NPROJ + COL_Q + h * 128;
                const bf16_t* Kh = base + COL_K + h * 128; const bf16_t* Vh = base + COL_V + h * 128;
                const int NT = S / 64, t0 = qb * 4;
                att::attn_pass<0>(Qb, Kh, Vh, NT, t0, qb * 256, mp, lam, args.in[15], stash, Qb, (char*)lds);
                att::attn_pass<1>(Qb + 64, Kh + 64, Vh, NT, t0, qb * 256, mp, lam, args.in[15], stash, Qb, (char*)lds);
#endif
            } else {
#ifndef NO_LRU
                int s, n, S;
                if (u < U_AS + U_AP + U_LS) { const int u2 = u - (U_AS + U_AP); s = 16 + (u2 >> 3); n = u2 & 7; S = S_S; }
                else { const int u2 = u - (U_AS + U_AP + U_LS); s = u2 >> 3; n = u2 & 7; S = S_P; }
                const long R0 = (s < 16) ? (long)s * S_P : (long)PROMPT_ROWS + (long)(s - 16) * S_S;
                lru::lru_dir<0>(PROJ, HF, R0, S, n, args.in[4], args.in[5], args.in[6], args.in[7], args.in[8], args.in[9], args.in[10], (char*)lds);
                lru::lru_dir<1>(PROJ, HF, R0, S, n, args.in[4], args.in[5], args.in[6], args.in[7], args.in[8], args.in[9], args.in[10], (char*)lds);
#endif
            }
        }
    }
    grid.sync();

    if (PH_MASK & 8) { pg8::Gemm g{PROJ, Wout_t, NPROJ, MTOK, DM, DM}; pg8::StaticOrder S; S.init(MTOK, DM, G, bx);
      pg8::EpiResid<true> E{x_p, x_s, out, XN, SSQ};
      pg8::gemm_phase((LAS unsigned char*)lds, g, S, E); }
    grid.sync();

    if (PH_MASK & 16) { pg8::Gemm g{XN, Wgu_t, DM, MTOK, NGU, DM}; pg8::StaticOrder S; S.init(MTOK, NGU, G, bx);
      pg8::EpiSwiGLU E{SSQ, HB};
      pg8::gemm_phase((LAS unsigned char*)lds, g, S, E); }
    grid.sync();

    if (PH_MASK & 32) { pg8::Gemm g{HB, Wdn_t, DFF, MTOK, DM, DFF}; pg8::StaticOrder S; S.init(MTOK, DM, G, bx);
      pg8::EpiResid<false> E{out, out + (size_t)PROMPT_ROWS * DM, out, nullptr, SSQ};
      pg8::gemm_phase((LAS unsigned char*)lds, g, S, E); }
    grid.sync();

    if (PH_MASK & 64) {
        const f32x4* g4 = (const f32x4*)args.in[21];
        for (int m = gw; m < MTOK; m += NGW) {
            float sv = (lane < 16) ? SSQ[(size_t)m * 16 + lane] : 0.f;
            sv += __shfl_xor(sv, 1); sv += __shfl_xor(sv, 2); sv += __shfl_xor(sv, 4); sv += __shfl_xor(sv, 8);
            const float tot = __shfl(sv, 0);
            const float rstd = __builtin_amdgcn_rsqf(tot * (1.0f / DM) + EPS);
            f32x4* xr = (f32x4*)(out + (size_t)m * DM) + lane;
#pragma unroll
            for (int j = 0; j < 4; ++j) { const f32x4 gg = g4[lane + 64 * j]; f32x4 v = xr[64 * j]; v.x *= rstd * gg.x; v.y *= rstd * gg.y; v.z *= rstd * gg.z; v.w *= rstd * gg.w; xr[64 * j] = v; }
        }
    }
}

extern "C" void kernel_launch(void* const* d_in, const int* in_sizes, int n_in, void* d_out, int out_size, void* d_ws, size_t ws_size, hipStream_t stream) {
    static int grid_blocks = 0;
    if (grid_blocks == 0) {
        if (n_in != 22 || in_sizes[0] != PROMPT_ROWS * DM || in_sizes[1] != PROMPT_ROWS * DM || out_size != MTOK * DM || ws_size < WS_END) {
            fprintf(stderr, "kernel_launch: shape mismatch (n_in %d, in0 %d, out %d, ws %zu)\n", n_in, n_in > 0 ? in_sizes[0] : -1, out_size, ws_size); grid_blocks = -1; return; }
        int dev = 0, cus = 0, per_cu = 0;
        hipGetDevice(&dev);
        hipDeviceGetAttribute(&cus, hipDeviceAttributeMultiprocessorCount, dev);
        if (hipFuncSetAttribute((const void*)mega_fwd, hipFuncAttributeMaxDynamicSharedMemorySize, LDS_BYTES) != hipSuccess) { fprintf(stderr, "kernel_launch: hipFuncSetAttribute failed\n"); grid_blocks = -1; return; }
        if (hipOccupancyMaxActiveBlocksPerMultiprocessor(&per_cu, (const void*)mega_fwd, NTHREADS, LDS_BYTES) != hipSuccess || per_cu < 1) { fprintf(stderr, "kernel_launch: occupancy query failed (%d)\n", per_cu); grid_blocks = -1; return; }
        grid_blocks = cus * 1;
    }
    if (grid_blocks < 0) return;
    Args a{};
    for (int i = 0; i < 22; ++i) a.in[i] = (const float*)d_in[i];
    a.out = (float*)d_out; a.ws = (unsigned char*)d_ws;
    void* kargs[] = {&a};
    hipError_t e = hipLaunchCooperativeKernel((const void*)mega_fwd, dim3(grid_blocks), dim3(NTHREADS), kargs, LDS_BYTES, stream);
    if (e != hipSuccess) fprintf(stderr, "kernel_launch: cooperative launch failed: %s (grid %d)\n", hipGetErrorString(e), grid_blocks);
}
```

```cpp
#include <hip/hip_runtime.h>
#include <hip/hip_cooperative_groups.h>
#include <cstdio>
#include <cstdint>
namespace cg = cooperative_groups;

#define LAS __attribute__((address_space(3)))
typedef unsigned short bf16_t;
typedef short bf16x8 __attribute__((ext_vector_type(8)));
typedef short s16x4 __attribute__((ext_vector_type(4)));
typedef float f32x2 __attribute__((ext_vector_type(2)));
typedef float f32x4 __attribute__((ext_vector_type(4)));
typedef float f32x16 __attribute__((ext_vector_type(16)));
typedef unsigned u32x2 __attribute__((ext_vector_type(2)));
typedef unsigned u32x4 __attribute__((ext_vector_type(4)));

constexpr int DM = 1024, MTOK = 65536, NPROJ = 2560, DFF = 2816, NGU = 2 * DFF;
constexpr int PROMPT_ROWS = 32768, S_P = 2048, S_S = 4096;
constexpr int COL_Q = 0, COL_G = 512, COL_K = 1024, COL_V = 1536, COL_XR = 2048;
constexpr float EPS = 1e-6f;
constexpr float LOG2E = 1.4426950408889634f;
constexpr float QSCALE = 0.125f * LOG2E;
constexpr int NWAVES = 8, NTHREADS = 512;

constexpr size_t MiB = 1u << 20;
constexpr size_t WS_CTL = 0, CTL_BYTES = 65536;
constexpr size_t WS_WIN = 1 * MiB, WS_WOUT = 6 * MiB, WS_WGU = 8 * MiB, WS_WDN = 19 * MiB;
constexpr size_t WS_SSQ = 25 * MiB;
constexpr size_t WS_XN = 32 * MiB;
constexpr size_t WS_HF = 32 * MiB;
constexpr size_t WS_STASH = 96 * MiB;
constexpr size_t WS_PROJ = 160 * MiB;
constexpr size_t WS_H = 160 * MiB;
constexpr size_t WS_END = 512 * MiB;

constexpr int LDS_BYTES = 147456;

__device__ __forceinline__ unsigned cvt_pk_bf16(float lo, float hi) { unsigned r; asm volatile("v_cvt_pk_bf16_f32 %0, %1, %2" : "=v"(r) : "v"(lo), "v"(hi)); return r; }
__device__ __forceinline__ float bf16lo(unsigned u) { return __uint_as_float(u << 16); }
__device__ __forceinline__ float bf16hi(unsigned u) { return __uint_as_float(u & 0xffff0000u); }
__device__ __forceinline__ float wave_sum(float v) {
#pragma unroll
    for (int o = 1; o < 64; o <<= 1) v += __shfl_xor(v, o);
    return v;
}
__device__ __forceinline__ float fast_sigmoid(float x) { return __builtin_amdgcn_rcpf(1.0f + __builtin_amdgcn_exp2f(-LOG2E * x)); }

namespace pg8 {
constexpr int BM = 256, BK = 64, HALF = 128, HTB = HALF * BK * 2, STAGE_BYTES = 8 * HTB, NXCD = 8, WGM = 8;
__host__ __device__ __forceinline__ int lds_byte(int r, int c) { const int st = (r >> 4) * 2 + (c >> 5), rr = r & 15, cc = c & 31, ob = rr * 64 + cc * 2; return st * 1024 + (ob ^ (((ob >> 9) & 1) << 5)); }
__host__ __device__ __forceinline__ void stage_rc(int b, int& R, int& C) { const int st = b / 1024, sb = b % 1024, swz = sb ^ (((sb >> 9) & 1) << 5); R = (st >> 1) * 16 + swz / 64; C = (st & 1) * 32 + (swz % 64) / 2; }
__host__ __device__ __forceinline__ int perm32(int rho) { const int n = rho >> 4, i = rho & 15; return 8 * (i >> 2) + 4 * n + (i & 3); }

struct Unit { int pm, pn; };
struct Gemm { const bf16_t* A; const bf16_t* Bt; int lda; int M, N, K; };

struct StaticOrder {
    int nM, nN, nwg, G, c;
    __device__ void init(int M, int N, int G_, int c_) { nM = M / BM; nN = N / BM; nwg = nM * nN; G = G_; c = c_; }
    __device__ bool next(int i, Unit& u) const {
        const long L = (long)i * G + c; if (L >= nwg) return false;
        int wgid = (int)L; { const int q = nwg / NXCD, r = nwg % NXCD, xcd = wgid % NXCD, off = wgid / NXCD; wgid = (xcd < r ? xcd * (q + 1) : r * (q + 1) + (xcd - r) * q) + off; }
        const int nig = WGM * nN, gid = wgid / nig, fm = gid * WGM, gsz = (nM - fm) < WGM ? (nM - fm) : WGM;
        u.pm = fm + ((wgid % nig) % gsz); u.pn = (wgid % nig) / gsz; return true;
    }
};


struct EpiStoreBf16 {
    bf16_t* O; int ldc;
    __device__ __forceinline__ void operator()(const f32x4 (&acc)[2][2][4][2], const Unit& u, int wr, int wc, int fr, int fq) const {
        const int row0 = u.pm * BM + wr * 64 + fr, col0 = u.pn * BM + wc * 32 + 8 * fq;
#pragma unroll
        for (int ai = 0; ai < 2; ++ai)
#pragma unroll
            for (int m = 0; m < 4; ++m) { bf16_t* rowp = O + (size_t)(row0 + ai * HALF + m * 16) * ldc + col0;
#pragma unroll
                for (int bj = 0; bj < 2; ++bj) { const f32x4 v0 = acc[ai][bj][m][0], v1 = acc[ai][bj][m][1];
                    u32x4 w; w.x = cvt_pk_bf16(v0[0], v0[1]); w.y = cvt_pk_bf16(v0[2], v0[3]); w.z = cvt_pk_bf16(v1[0], v1[1]); w.w = cvt_pk_bf16(v1[2], v1[3]);
                    *(u32x4*)(rowp + bj * HALF) = w; } }
    }
};
template <bool WRITE_BF16> struct EpiResid {
    const float* r0; const float* r1;
    float* out; bf16_t* xn; float* ssq;
    __device__ __forceinline__ void operator()(const f32x4 (&acc)[2][2][4][2], const Unit& u, int wr, int wc, int fr, int fq) const {
        const int row0 = u.pm * BM + wr * 64 + fr, col0 = u.pn * BM + wc * 32 + 8 * fq;
        const float* rbase = (row0 < PROMPT_ROWS) ? r0 : (r1 - (size_t)PROMPT_ROWS * DM);
#pragma unroll
        for (int ai = 0; ai < 2; ++ai)
#pragma unroll
            for (int m = 0; m < 4; ++m) { const int row = row0 + ai * HALF + m * 16; const float* rp = rbase + (size_t)row * DM + col0; float* op = out + (size_t)row * DM + col0;
                float ss = 0.f;
#pragma unroll
                for (int bj = 0; bj < 2; ++bj) { const f32x4 a0 = *(const f32x4*)(rp + bj * HALF), a1 = *(const f32x4*)(rp + bj * HALF + 4);
                    const f32x4 v0 = acc[ai][bj][m][0] + a0, v1 = acc[ai][bj][m][1] + a1;
                    ss += (v0[0] * v0[0] + v0[1] * v0[1]) + (v0[2] * v0[2] + v0[3] * v0[3]); ss += (v1[0] * v1[0] + v1[1] * v1[1]) + (v1[2] * v1[2] + v1[3] * v1[3]);
                    *(f32x4*)(op + bj * HALF) = v0; *(f32x4*)(op + bj * HALF + 4) = v1;
                    if (WRITE_BF16) { u32x4 w; w.x = cvt_pk_bf16(v0[0], v0[1]); w.y = cvt_pk_bf16(v0[2], v0[3]); w.z = cvt_pk_bf16(v1[0], v1[1]); w.w = cvt_pk_bf16(v1[2], v1[3]);
                        *(u32x4*)(xn + (size_t)row * DM + col0 + bj * HALF) = w; } }
                ss += __shfl_xor(ss, 16); ss += __shfl_xor(ss, 32);
                if (fq == 0) ssq[(size_t)row * 16 + u.pn * 4 + wc] = ss; }
    }
};
struct EpiSwiGLU {
    const float* ssq; bf16_t* H;
    __device__ __forceinline__ void operator()(const f32x4 (&acc)[2][2][4][2], const Unit& u, int wr, int wc, int fr, int fq) const {
        const int row0 = u.pm * BM + wr * 64 + fr, col0 = u.pn * HALF + wc * 32 + 8 * fq;
#pragma unroll
        for (int ai = 0; ai < 2; ++ai)
#pragma unroll
            for (int m = 0; m < 4; ++m) { const int row = row0 + ai * HALF + m * 16;
                const f32x4* sp = (const f32x4*)(ssq + (size_t)row * 16); const f32x4 s0 = sp[0], s1 = sp[1], s2 = sp[2], s3 = sp[3];
                const f32x4 st = (s0 + s1) + (s2 + s3); const float tot = (st[0] + st[1]) + (st[2] + st[3]);
                const float rstd = __builtin_amdgcn_rsqf(tot * (1.0f / DM) + EPS);
                float o[8];
#pragma unroll
                for (int n = 0; n < 2; ++n)
#pragma unroll
                    for (int e = 0; e < 4; ++e) { const float g = acc[ai][0][m][n][e] * rstd, up = acc[ai][1][m][n][e] * rstd; o[n * 4 + e] = g * up * fast_sigmoid(g); }
                u32x4 w; w.x = cvt_pk_bf16(o[0], o[1]); w.y = cvt_pk_bf16(o[2], o[3]); w.z = cvt_pk_bf16(o[4], o[5]); w.w = cvt_pk_bf16(o[6], o[7]);
                *(u32x4*)(H + (size_t)row * DFF + col0) = w; }
    }
};

template <class Epi>
__device__ __forceinline__ void gemm_phase(LAS unsigned char* lds, const Gemm g, const StaticOrder& S, const Epi& E) {
    int tid = threadIdx.x; asm volatile("" : "+v"(tid));
    const int wid = __builtin_amdgcn_readfirstlane(tid >> 6), lane = tid & 63, wr = wid >> 2, wc = wid & 3, fr = lane & 15, fq = lane >> 4;
    const int K = g.K, nt = K / BK, lda = g.lda;
    unsigned voffA[2], voffB[2];
#pragma unroll
    for (int i = 0; i < 2; ++i) { int R, C; stage_rc(tid * 16 + i * 8192, R, C); const int Rb = (R & ~31) + perm32(R & 31);
        voffA[i] = (unsigned)(R * lda + C) * 2u; voffB[i] = (unsigned)(Rb * K + C) * 2u; }
    const size_t kstep = (size_t)(BK * 2);
    const size_t hstepA = (size_t)HALF * lda * 2, hstepB = (size_t)HALF * K * 2;
    const size_t tstepA = 2 * hstepA, tstepB = 2 * hstepB;
    const unsigned ldsw = (unsigned)wid * 1024u;
    const int aoff = lds_byte(wr * 64 + fr, fq * 8), boff = lds_byte(wc * 32 + fr, fq * 8);
#define PG8_SA(b, h) (((b) * 2 + (h)) * HTB)
#define PG8_SB(b, h) ((4 + (b) * 2 + (h)) * HTB)
#define PG8_STAGE(bufoff, gbase, voff) do { _Pragma("unroll") for (int _i = 0; _i < 2; ++_i) \
        __builtin_amdgcn_global_load_lds((const unsigned*)((const char*)(gbase) + (voff)[_i]), (LAS unsigned*)(lds + (bufoff) + ldsw + _i * 8192), 16, 0, 0); } while (0)
#define PG8_LDA(dst, b, h) do { _Pragma("unroll") for (int m = 0; m < 4; ++m) _Pragma("unroll") for (int k = 0; k < 2; ++k) dst[m][k] = *(const LAS bf16x8*)(lds + PG8_SA(b, h) + aoff + m * 2048 + k * 1024); } while (0)
#define PG8_LDB(dst, b, h) do { _Pragma("unroll") for (int n = 0; n < 2; ++n) _Pragma("unroll") for (int k = 0; k < 2; ++k) dst[n][k] = *(const LAS bf16x8*)(lds + PG8_SB(b, h) + boff + n * 2048 + k * 1024); } while (0)
#define PG8_MMA(ai, bj, At, Bt) do { __builtin_amdgcn_s_setprio(1); _Pragma("unroll") for (int m = 0; m < 4; ++m) _Pragma("unroll") for (int n = 0; n < 2; ++n) _Pragma("unroll") for (int k = 0; k < 2; ++k) \
        acc[ai][bj][m][n] = __builtin_amdgcn_mfma_f32_16x16x32_bf16(Bt[n][k], At[m][k], acc[ai][bj][m][n], 0, 0, 0); __builtin_amdgcn_s_setprio(0); } while (0)
#define PG8_WAIT_V(n) asm volatile("s_waitcnt vmcnt(" #n ")" ::: "memory")
#define PG8_WAIT_L(n) asm volatile("s_waitcnt lgkmcnt(" #n ")" ::: "memory")
#define PG8_BAR __builtin_amdgcn_s_barrier()
#define PG8_SCHED __builtin_amdgcn_sched_barrier(0)
    Unit cur, nxt; int ui = 0;
    if (!S.next(0, cur)) return;
    f32x4 acc[2][2][4][2];
#pragma unroll
    for (int a = 0; a < 2; ++a)
#pragma unroll
        for (int b = 0; b < 2; ++b)
#pragma unroll
            for (int m = 0; m < 4; ++m)
#pragma unroll
                for (int n = 0; n < 2; ++n) acc[a][b][m][n] = (f32x4){0.f, 0.f, 0.f, 0.f};
    bf16x8 At[4][2], B0[2][2], B1[2][2];
    const char* cA = (const char*)g.A + (size_t)cur.pm * tstepA; const char* cB = (const char*)g.Bt + (size_t)cur.pn * tstepB;
    PG8_STAGE(PG8_SB(0, 0), cB, voffB); PG8_STAGE(PG8_SB(0, 1), cB + hstepB, voffB); PG8_STAGE(PG8_SA(0, 0), cA, voffA); PG8_STAGE(PG8_SA(0, 1), cA + hstepA, voffA);
    if (wr == 1) PG8_BAR;
    PG8_WAIT_V(2); PG8_BAR;
    PG8_STAGE(PG8_SB(1, 0), cB + kstep, voffB); PG8_STAGE(PG8_SA(1, 0), cA + kstep, voffA); PG8_STAGE(PG8_SB(1, 1), cB + hstepB + kstep, voffB);
    PG8_WAIT_V(6); PG8_BAR;
    for (;;) {
        const bool has_next = S.next(ui + 1, nxt);
        const char* nA = has_next ? (const char*)g.A + (size_t)nxt.pm * tstepA : cA; const char* nB = has_next ? (const char*)g.Bt + (size_t)nxt.pn * tstepB : cB;
        for (int t = 0; t < nt; t += 2) {
            const bool last = (t == nt - 2);
            const char* a1 = cA + (size_t)(t + 1) * kstep;
            const char* a2 = last ? nA : cA + (size_t)(t + 2) * kstep; const char* b2 = last ? nB : cB + (size_t)(t + 2) * kstep;
            const char* a3 = a2 + kstep; const char* b3 = b2 + kstep;
            PG8_LDB(B0, 0, 0); PG8_LDB(B1, 0, 1); PG8_SCHED; PG8_LDA(At, 0, 0); PG8_STAGE(PG8_SA(1, 1), a1 + hstepA, voffA);
            PG8_WAIT_V(8); PG8_WAIT_L(0); PG8_BAR; PG8_MMA(0, 0, At, B0); PG8_MMA(0, 1, At, B1); PG8_BAR; PG8_SCHED;
            PG8_LDA(At, 0, 1); PG8_STAGE(PG8_SB(0, 0), b2, voffB); PG8_STAGE(PG8_SB(0, 1), b2 + hstepB, voffB); PG8_STAGE(PG8_SA(0, 0), a2, voffA);
            PG8_WAIT_V(8); PG8_WAIT_L(0); PG8_BAR; PG8_MMA(1, 0, At, B0); PG8_MMA(1, 1, At, B1); PG8_BAR; PG8_SCHED;
            PG8_LDB(B0, 1, 0); PG8_LDB(B1, 1, 1); PG8_SCHED; PG8_LDA(At, 1, 0); PG8_STAGE(PG8_SA(0, 1), a2 + hstepA, voffA);
            PG8_WAIT_V(8); PG8_WAIT_L(0); PG8_BAR; PG8_MMA(0, 0, At, B0); PG8_MMA(0, 1, At, B1); PG8_BAR; PG8_SCHED;
            PG8_LDA(At, 1, 1); PG8_STAGE(PG8_SB(1, 0), b3, voffB); PG8_STAGE(PG8_SB(1, 1), b3 + hstepB, voffB); PG8_STAGE(PG8_SA(1, 0), a3, voffA);
            PG8_WAIT_V(8); PG8_WAIT_L(0); PG8_BAR; PG8_MMA(1, 0, At, B0); PG8_MMA(1, 1, At, B1); PG8_BAR; PG8_SCHED;
        }
        if (wr == 0) PG8_BAR;
        E(acc, cur, wr, wc, fr, fq);
        if (!has_next) break;
#pragma unroll
        for (int a = 0; a < 2; ++a)
#pragma unroll
            for (int b = 0; b < 2; ++b)
#pragma unroll
                for (int m = 0; m < 4; ++m)
#pragma unroll
                    for (int n = 0; n < 2; ++n) acc[a][b][m][n] = (f32x4){0.f, 0.f, 0.f, 0.f};
        cur = nxt; cA = nA; cB = nB; ++ui;
        if (wr == 1) PG8_BAR;
    }
    PG8_WAIT_V(0);
    PG8_BAR;
#undef PG8_SA
#undef PG8_SB
#undef PG8_STAGE
#undef PG8_LDA
#undef PG8_LDB
#undef PG8_MMA
#undef PG8_WAIT_V
#undef PG8_WAIT_L
#undef PG8_BAR
#undef PG8_SCHED
}
}

namespace att {
constexpr int PITCH = NPROJ, QBLK = 32, KVBLK = 64;
constexpr int SHM_V = KVBLK * 128 * 2, SHM_K = KVBLK * 64 * 2, OFF_K = 2 * SHM_V, OFF_WS = OFF_K + 2 * SHM_K;
constexpr float THR = 8.f;
#define KSWZ64(row, cb) ((row) * 128 + ((cb) ^ ((((row) >> 1) & 7) << 4)))
#define SBAR() __builtin_amdgcn_sched_barrier(0)
__device__ __forceinline__ int crow(int r, int hi) { return (r & 3) + 8 * (r >> 2) + 4 * hi; }

__device__ __forceinline__ void partialSM(f32x16& p0, f32x16& p1, float& m_reg, float& alpha, float mp, float dj0) {
#pragma unroll
    for (int r = 0; r < 16; ++r) { const float c = (float)((r & 3) + 8 * (r >> 2));
        p0[r] = __builtin_fmaf(-mp, __builtin_fabsf(dj0 + c), p0[r]); p1[r] = __builtin_fmaf(-mp, __builtin_fabsf(dj0 + (c + 32.f)), p1[r]); }
    float pmax = p0[0];
#pragma unroll
    for (int r = 1; r < 16; ++r) pmax = fmaxf(pmax, p0[r]);
#pragma unroll
    for (int r = 0; r < 16; ++r) pmax = fmaxf(pmax, p1[r]);
    { auto rr = __builtin_amdgcn_permlane32_swap(__float_as_uint(pmax), __float_as_uint(pmax), false, false);
      pmax = fmaxf(__uint_as_float(rr[0]), __uint_as_float(rr[1])); }
    float mn;
    if (__builtin_expect(__all(pmax - m_reg <= THR), 1)) { mn = m_reg; alpha = 1.f; }
    else { mn = fmaxf(m_reg, pmax); alpha = __builtin_amdgcn_exp2f(m_reg - mn); m_reg = mn; }
#pragma unroll
    for (int r = 0; r < 16; ++r) { p0[r] -= mn; p1[r] -= mn; }
#pragma unroll
    for (int r = 0; r < 16; ++r) p0[r] = __builtin_amdgcn_exp2f(p0[r]);
}
__device__ __forceinline__ void finishSM(f32x16& p0, f32x16& p1, float alpha, float& l_reg, bf16x8& pa0, bf16x8& pa1, bf16x8& pa2, bf16x8& pa3) {
#pragma unroll
    for (int r = 0; r < 16; ++r) p1[r] = __builtin_amdgcn_exp2f(p1[r]);
    float ps = 0;
#pragma unroll
    for (int r = 0; r < 16; ++r) ps += p0[r];
#pragma unroll
    for (int r = 0; r < 16; ++r) ps += p1[r];
    { auto rr = __builtin_amdgcn_permlane32_swap(__float_as_uint(ps), __float_as_uint(ps), false, false);
      ps = __uint_as_float(rr[0]) + __uint_as_float(rr[1]); }
    l_reg = l_reg * alpha + ps;
#define PK4(P, BASE, OUT) do { unsigned a0 = cvt_pk_bf16(P[BASE + 0], P[BASE + 1]), a1 = cvt_pk_bf16(P[BASE + 2], P[BASE + 3]);   \
    unsigned b0 = cvt_pk_bf16(P[BASE + 4], P[BASE + 5]), b1 = cvt_pk_bf16(P[BASE + 6], P[BASE + 7]);                              \
    auto r0 = __builtin_amdgcn_permlane32_swap(a0, b0, false, false); auto r1 = __builtin_amdgcn_permlane32_swap(a1, b1, false, false); \
    u32x4 w = {r0[0], r1[0], r0[1], r1[1]}; OUT = *reinterpret_cast<bf16x8*>(&w); } while (0)
    PK4(p0, 0, pa0); PK4(p0, 8, pa1); PK4(p1, 0, pa2); PK4(p1, 8, pa3);
#undef PK4
}
__device__ __forceinline__ void qkt(f32x16& p0, f32x16& p1, const char* Ks, const bf16x8* qr, int r32, int hi) {
    p0 = f32x16{}; p1 = f32x16{};
#pragma unroll
    for (int d0 = 0; d0 < 4; ++d0) { const int cb = d0 * 32 + hi * 16;
        const bf16x8 b0 = *reinterpret_cast<const bf16x8*>(Ks + KSWZ64(r32, cb));
        const bf16x8 b1 = *reinterpret_cast<const bf16x8*>(Ks + KSWZ64(32 + r32, cb));
        p0 = __builtin_amdgcn_mfma_f32_32x32x16_bf16(b0, qr[d0], p0, 0, 0, 0);
        p1 = __builtin_amdgcn_mfma_f32_32x32x16_bf16(b1, qr[d0], p1, 0, 0, 0); }
}
__device__ __forceinline__ int v_st(int k, int c) { const int kk = (k & ~0xC) | ((k & 4) << 1) | ((k & 8) >> 1); return ((kk >> 3) * 4 + (c >> 5)) * 512 + ((kk & 7) * 32 + (c & 31)) * 2; }
__device__ __forceinline__ int v_rd_base(int lane) { return ((lane & 3) << 3) | (((lane >> 2) & 3) << 6) | (((lane >> 4) & 1) << 5) | (((lane >> 5) & 1) << 8); }
constexpr int v_rd_off(int d0, int ks, int half) { return d0 * 512 + ks * 4096 + half * 2048; }
template <int OFF> __device__ __forceinline__ s16x4 tr_read(int vb) {
    s16x4 r; asm volatile("ds_read_b64_tr_b16 %0, %1 offset:%2" : "=&v"(r) : "v"(vb), "i"(OFF) : "memory"); return r;
}
template <int D0> __device__ __forceinline__ void pv_one(f32x16& od, int vb, bf16x8 pa0, bf16x8 pa1, bf16x8 pa2, bf16x8 pa3) {
    const s16x4 l0 = tr_read<v_rd_off(D0, 0, 0)>(vb), h0 = tr_read<v_rd_off(D0, 0, 1)>(vb), l1 = tr_read<v_rd_off(D0, 1, 0)>(vb), h1 = tr_read<v_rd_off(D0, 1, 1)>(vb);
    const s16x4 l2 = tr_read<v_rd_off(D0, 2, 0)>(vb), h2 = tr_read<v_rd_off(D0, 2, 1)>(vb), l3 = tr_read<v_rd_off(D0, 3, 0)>(vb), h3 = tr_read<v_rd_off(D0, 3, 1)>(vb);
    asm volatile("s_waitcnt lgkmcnt(0)" ::: "memory"); SBAR();
#define PK(L, H) (bf16x8){L[0], L[1], L[2], L[3], H[0], H[1], H[2], H[3]}
    od = __builtin_amdgcn_mfma_f32_32x32x16_bf16(pa0, PK(l0, h0), od, 0, 0, 0);
    od = __builtin_amdgcn_mfma_f32_32x32x16_bf16(pa1, PK(l1, h1), od, 0, 0, 0);
    od = __builtin_amdgcn_mfma_f32_32x32x16_bf16(pa2, PK(l2, h2), od, 0, 0, 0);
    od = __builtin_amdgcn_mfma_f32_32x32x16_bf16(pa3, PK(l3, h3), od, 0, 0, 0);
#undef PK
}
__device__ __forceinline__ void pv_d0(f32x16* o, int vb, bf16x8 pa0, bf16x8 pa1, bf16x8 pa2, bf16x8 pa3) {
    pv_one<0>(o[0], vb, pa0, pa1, pa2, pa3); pv_one<1>(o[1], vb, pa0, pa1, pa2, pa3); pv_one<2>(o[2], vb, pa0, pa1, pa2, pa3); pv_one<3>(o[3], vb, pa0, pa1, pa2, pa3);
}

template <int PASS>
__device__ __forceinline__ void attn_pass(const bf16_t* __restrict__ Qb, const bf16_t* __restrict__ Kh, const bf16_t* __restrict__ Vh, int NT, int t0, int ipos0, float mp,
                                          float lam, const float* __restrict__ subg, float* stash, bf16_t* Ob, int opitch, char* lds) {
    int tid = threadIdx.x; asm volatile("" : "+v"(tid));
    const int wid = tid >> 6, lane = tid & 63, r32 = lane & 31, hi = lane >> 5;
    char* V_lds = lds; char* K_lds = lds + OFF_K;
    float* ws = (float*)(lds + OFF_WS) + wid * 64; float* li_l = ws; float* al_l = ws + 32;
    float m_reg = -1e30f, l_reg = 0; f32x16 o[4] = {}; bf16x8 qr[4];
    const bf16_t* Qw = Qb + (long)(wid * QBLK + r32) * PITCH + hi * 8;
#pragma unroll
    for (int d0 = 0; d0 < 4; ++d0) qr[d0] = *reinterpret_cast<const bf16x8*>(Qw + d0 * 16);
    const int sr = tid >> 4, sc = (tid & 15) * 8, vst0 = v_st(sr, sc), vst1 = v_st(32 + sr, sc);
    const int kr = tid >> 3, kc = (tid & 7) * 8, kst = KSWZ64(kr, kc * 2);
    const int vb0 = (int)(uintptr_t)V_lds + v_rd_base(lane);
    const int ipos = ipos0 + wid * QBLK + r32;
    struct { bf16x8 vs0, vs1, ks0; } sr_[2];
#define TJ(j) ((t0 + (j)) & (NT - 1))
#define DJ0(j) ((float)(TJ(j) * KVBLK + 4 * hi - ipos))
#define SLOAD(i, j) do { const long k0_ = (long)TJ(j) * KVBLK; sr_[i].vs0 = *reinterpret_cast<const bf16x8*>(&Vh[(k0_ + sr) * PITCH + sc]); \
    sr_[i].vs1 = *reinterpret_cast<const bf16x8*>(&Vh[(k0_ + 32 + sr) * PITCH + sc]); sr_[i].ks0 = *reinterpret_cast<const bf16x8*>(&Kh[(k0_ + kr) * PITCH + kc]); } while (0)
#define SWRITE(b, i) do { *(bf16x8*)(V_lds + (b) * SHM_V + vst0) = sr_[i].vs0; *(bf16x8*)(V_lds + (b) * SHM_V + vst1) = sr_[i].vs1; \
    *(bf16x8*)(K_lds + (b) * SHM_K + kst) = sr_[i].ks0; } while (0)
#define SWAIT() asm volatile("s_waitcnt vmcnt(3)" ::: "memory")
#define RESC(a) do { if (__any((a) < 1.f)) { if (hi == 0) al_l[r32] = (a); asm volatile("s_waitcnt lgkmcnt(0)" ::: "memory"); \
    _Pragma("unroll") for (int d = 0; d < 4; ++d) _Pragma("unroll") for (int r = 0; r < 16; ++r) o[d][r] *= al_l[crow(r, hi)]; } } while (0)
    f32x16 pA0, pA1, pB0, pB1; float alA, alB; bf16x8 pa0, pa1, pa2, pa3;
    constexpr int SE = 0, SO = 1;
    SLOAD(SE, 0); asm volatile("s_waitcnt vmcnt(0)" ::: "memory"); SWRITE(0, SE); __syncthreads();
    qkt(pA0, pA1, K_lds, qr, r32, hi); partialSM(pA0, pA1, m_reg, alA, mp, DJ0(0));
    SLOAD(SO, 1); if (2 < NT) SLOAD(SE, 2);
    SWAIT(); SWRITE(1, SO); __syncthreads();
    for (int j = 1; j + 1 < NT; j += 2) {
        SBAR(); qkt(pB0, pB1, K_lds + SHM_K, qr, r32, hi);
        finishSM(pA0, pA1, alA, l_reg, pa0, pa1, pa2, pa3); SBAR();
        SLOAD(SO, j + 2); SBAR();
        pv_d0(o, vb0, pa0, pa1, pa2, pa3); partialSM(pB0, pB1, m_reg, alB, mp, DJ0(j));
        __syncthreads(); SWAIT(); SWRITE(0, SE);
        RESC(alB); __syncthreads();
        SBAR(); qkt(pA0, pA1, K_lds, qr, r32, hi);
        finishSM(pB0, pB1, alB, l_reg, pa0, pa1, pa2, pa3); SBAR();
        if (j + 3 < NT) SLOAD(SE, j + 3); SBAR();
        pv_d0(o, vb0 + SHM_V, pa0, pa1, pa2, pa3); partialSM(pA0, pA1, m_reg, alA, mp, DJ0(j + 1));
        __syncthreads(); SWAIT(); SWRITE(1, SO);
        RESC(alA); __syncthreads();
    }
    SBAR(); qkt(pB0, pB1, K_lds + SHM_K, qr, r32, hi);
    finishSM(pA0, pA1, alA, l_reg, pa0, pa1, pa2, pa3); SBAR();
    pv_d0(o, vb0, pa0, pa1, pa2, pa3); partialSM(pB0, pB1, m_reg, alB, mp, DJ0(NT - 1));
    __syncthreads(); RESC(alB);
    finishSM(pB0, pB1, alB, l_reg, pa0, pa1, pa2, pa3); SBAR();
    pv_d0(o, vb0 + SHM_V, pa0, pa1, pa2, pa3);
    if (hi == 0) li_l[r32] = l_reg; asm volatile("s_waitcnt lgkmcnt(0)" ::: "memory");
    float rli[16];
#pragma unroll
    for (int r = 0; r < 16; ++r) rli[r] = __builtin_amdgcn_rcpf(li_l[crow(r, hi)]);
    float* st = stash + (long)(wid * QBLK) * 128 + r32;
    if (PASS == 0) {
#pragma unroll
        for (int r = 0; r < 16; ++r) { const int orow = crow(r, hi);
#pragma unroll
            for (int d0 = 0; d0 < 4; ++d0) st[orow * 128 + d0 * 32] = o[d0][r] * rli[r]; }
    } else {
        float g8[4];
#pragma unroll
        for (int d0 = 0; d0 < 4; ++d0) g8[d0] = 0.8f * subg[d0 * 32 + r32];
        bf16_t* Ow = Ob + (long)(wid * QBLK) * opitch + r32;
#pragma unroll
        for (int r = 0; r < 16; ++r) { const int orow = crow(r, hi); float ss = 0.f;
#pragma unroll
            for (int d0 = 0; d0 < 4; ++d0) { const float dl = st[orow * 128 + d0 * 32] - lam * (o[d0][r] * rli[r]); o[d0][r] = dl; ss += dl * dl; }
            ss += __shfl_xor(ss, 1); ss += __shfl_xor(ss, 2); ss += __shfl_xor(ss, 4); ss += __shfl_xor(ss, 8); ss += __shfl_xor(ss, 16);
            const float rn = __builtin_amdgcn_rsqf(ss * (1.0f / 128.0f) + EPS);
#pragma unroll
            for (int d0 = 0; d0 < 4; ++d0) Ow[(long)orow * opitch + d0 * 32] = (bf16_t)(cvt_pk_bf16(o[d0][r] * rn * g8[d0], 0.f) & 0xffffu); }
    }
    asm volatile("s_waitcnt vmcnt(0) lgkmcnt(0)" ::: "memory");
    __syncthreads();
#undef TJ
#undef DJ0
#undef SLOAD
#undef SWRITE
#undef SWAIT
#undef RESC
}
}

namespace lru {
constexpr int T = 128, PITCH = NPROJ;
constexpr int OFF_XC = 0, OFF_G = 16384, OFF_CAR = OFF_G + T * 128 * 4, OFF_CIN = OFF_CAR + 16 * 64 * 8;
__device__ __forceinline__ int crow(int r, int hi) { return (r & 3) + 8 * (r >> 2) + 4 * hi; }
__device__ __forceinline__ float gelu_tanh(float x) { const float u = 0.7978845608028654f * (x + 0.044715f * x * x * x); return x * fast_sigmoid(2.0f * u); }

template <int DIR, bool DRY = false>
__device__ __forceinline__ void lru_dir(bf16_t* proj, bf16_t* hf, long R0, int S, int n, const float* __restrict__ conv_w, const float* __restrict__ conv_b,
                                        const float* __restrict__ w_rg, const float* __restrict__ b_rg, const float* __restrict__ w_ig, const float* __restrict__ b_ig,
                                        const float* __restrict__ lam, char* lds) {
    int tid = threadIdx.x; asm volatile("" : "+v"(tid));
    const int wid = tid >> 6, lane = tid & 63, r32 = lane & 31, hi = lane >> 5;
    const int cp = tid & 31, tsub = tid >> 5, c0 = 2 * cp;
    float* G = (float*)(lds + OFF_G); f32x2* CAR = (f32x2*)(lds + OFF_CAR); float* CIN = (float*)(lds + OFF_CIN);
    float cw[4][2], cb[2], k1[2];
#pragma unroll
    for (int e = 0; e < 2; ++e) { const int ch = n * 64 + c0 + e;
#pragma unroll
        for (int j = 0; j < 4; ++j) cw[j][e] = conv_w[j * 512 + ch];
        cb[e] = conv_b[ch];
        const float sp = log1pf(expf(-lam[DIR * 512 + ch]));
        k1[e] = -8.0f * sp * LOG2E; }
    const int ct = wid & 3, gtype = ct >> 1, dcol = (ct & 1) * 32 + r32;
    const float* Wg = (gtype ? w_ig : w_rg) + (size_t)(DIR * 8 + n) * 64 * 64;
    const float gbias = (gtype ? b_ig : b_rg)[DIR * 512 + n * 64 + dcol];
    bf16x8 bfr[4];
#pragma unroll
    for (int ks = 0; ks < 4; ++ks) { float wv[8];
#pragma unroll
        for (int j = 0; j < 8; ++j) wv[j] = Wg[(ks * 16 + 8 * hi + j) * 64 + dcol];
        u32x4 w; w.x = cvt_pk_bf16(wv[0], wv[1]); w.y = cvt_pk_bf16(wv[2], wv[3]); w.z = cvt_pk_bf16(wv[4], wv[5]); w.w = cvt_pk_bf16(wv[6], wv[7]);
        bfr[ks] = *reinterpret_cast<bf16x8*>(&w); }
    if (tid < 128) CIN[tid] = 0.f;
    __syncthreads();
    const int NC = S / T;
    unsigned xn_[11], hfn_[8], gtn_[8];
#define LRU_PREFETCH(ci_) do { const int ck_ = DIR ? (NC - 1 - (ci_)) : (ci_); const int tq_ = ck_ * T + 8 * tsub; \
        _Pragma("unroll") for (int k = 0; k < 11; ++k) { const int tb = tq_ - 2 + k; xn_[k] = 0u; \
            if (tb >= 0 && tb < S) xn_[k] = *(const unsigned*)(proj + (R0 + tb) * PITCH + COL_XR + n * 64 + c0); } \
        if (DIR) { _Pragma("unroll") for (int k = 0; k < 8; ++k) { const long row_ = R0 + tq_ + k; \
            hfn_[k] = *(const unsigned*)(hf + row_ * 512 + n * 64 + c0); gtn_[k] = *(const unsigned*)(proj + row_ * PITCH + COL_G + n * 64 + c0); } } } while (0)
    LRU_PREFETCH(0);
    for (int ci = 0; ci < NC; ++ci) {
        const int ck = DIR ? (NC - 1 - ci) : ci, t0 = ck * T, par = ci & 1;
        float xin[11][2]; unsigned hfv[8], gtv[8];
#pragma unroll
        for (int k = 0; k < 11; ++k) { xin[k][0] = bf16lo(xn_[k]); xin[k][1] = bf16hi(xn_[k]); }
#pragma unroll
        for (int k = 0; k < 8; ++k) { hfv[k] = hfn_[k]; gtv[k] = gtn_[k]; }
        if (ci + 1 < NC) LRU_PREFETCH(ci + 1);
        float xc[8][2];
#pragma unroll
        for (int k = 0; k < 8; ++k)
#pragma unroll
            for (int e = 0; e < 2; ++e) xc[k][e] = cb[e] + cw[0][e] * xin[k][e] + cw[1][e] * xin[k + 1][e] + cw[2][e] * xin[k + 2][e] + cw[3][e] * xin[k + 3][e];
#pragma unroll
        for (int k = 0; k < 8; ++k) { const int tl = 8 * tsub + k;
            *(unsigned*)(lds + OFF_XC + tl * 128 + ((((c0 >> 3) ^ ((tl >> 1) & 7))) << 4) + (c0 & 7) * 2) = cvt_pk_bf16(xc[k][0], xc[k][1]); }
        __syncthreads();
#pragma unroll
        for (int rt2 = 0; rt2 < 2; ++rt2) { const int rt = (wid >> 2) * 2 + rt2; f32x16 acc = {};
#pragma unroll
            for (int ks = 0; ks < 4; ++ks) { const int row = rt * 32 + r32, cbb = ks * 32 + hi * 16;
                const bf16x8 a = *reinterpret_cast<const bf16x8*>(lds + OFF_XC + row * 128 + (cbb ^ (((row >> 1) & 7) << 4)));
                acc = __builtin_amdgcn_mfma_f32_32x32x16_bf16(a, bfr[ks], acc, 0, 0, 0); }
#pragma unroll
            for (int r = 0; r < 16; ++r) G[(rt * 32 + crow(r, hi)) * 128 + ct * 32 + r32] = fast_sigmoid(acc[r] + gbias); }
        __syncthreads();
        float av[8][2], bv[8][2];
#pragma unroll
        for (int k = 0; k < 8; ++k) { const int tl = 8 * tsub + k; const f32x2 rg = *(const f32x2*)&G[tl * 128 + c0], ig = *(const f32x2*)&G[tl * 128 + 64 + c0];
#pragma unroll
            for (int e = 0; e < 2; ++e) { const float l2a = rg[e] * k1[e]; av[k][e] = __builtin_amdgcn_exp2f(l2a);
                const float x = l2a * (2.0f * 0.6931471805599453f);
                float q = 1.0f + x * (1.0f / 6.0f); q = 1.0f + x * 0.2f * q; q = 1.0f + x * 0.25f * q; q = 1.0f + x * (1.0f / 3.0f) * q; q = 1.0f + x * 0.5f * q;
                const float m2 = fmaxf(-x * q, 1e-12f);
                bv[k][e] = __builtin_amdgcn_sqrtf(m2) * ig[e] * xc[k][e]; } }
        float A[2] = {1.f, 1.f}, Hh[2] = {0.f, 0.f};
#pragma unroll
        for (int kk = 0; kk < 8; ++kk) { const int k = DIR ? 7 - kk : kk;
#pragma unroll
            for (int e = 0; e < 2; ++e) { Hh[e] = av[k][e] * Hh[e] + bv[k][e]; A[e] *= av[k][e]; } }
        CAR[tsub * 64 + c0] = (f32x2){A[0], Hh[0]}; CAR[tsub * 64 + c0 + 1] = (f32x2){A[1], Hh[1]};
        __syncthreads();
        float h[2] = {CIN[par * 64 + c0], CIN[par * 64 + c0 + 1]};
        if (DIR == 0) { for (int s = 0; s < tsub; ++s) { const f32x2 q0 = CAR[s * 64 + c0], q1 = CAR[s * 64 + c0 + 1]; h[0] = q0[0] * h[0] + q0[1]; h[1] = q1[0] * h[1] + q1[1]; } }
        else { for (int s = 15; s > tsub; --s) { const f32x2 q0 = CAR[s * 64 + c0], q1 = CAR[s * 64 + c0 + 1]; h[0] = q0[0] * h[0] + q0[1]; h[1] = q1[0] * h[1] + q1[1]; } }
#pragma unroll
        for (int kk = 0; kk < 8; ++kk) { const int k = DIR ? 7 - kk : kk; const long row = R0 + t0 + 8 * tsub + k;
            h[0] = av[k][0] * h[0] + bv[k][0]; h[1] = av[k][1] * h[1] + bv[k][1];
            if (DIR == 0) { *(unsigned*)(hf + row * 512 + n * 64 + c0) = cvt_pk_bf16(h[0], h[1]); }
            else { const unsigned hv = hfv[k]; unsigned* gp = (unsigned*)(proj + row * PITCH + COL_G + n * 64 + c0); const unsigned gv = gtv[k]; if (DRY) gp = (unsigned*)(hf + row * 512 + n * 64 + c0);
                const float y0 = (bf16lo(hv) + h[0]) * gelu_tanh(bf16lo(gv)), y1 = (bf16hi(hv) + h[1]) * gelu_tanh(bf16hi(gv));
                *gp = cvt_pk_bf16(y0, y1); } }
        if (tsub == (DIR ? 0 : 15)) { CIN[(par ^ 1) * 64 + c0] = h[0]; CIN[(par ^ 1) * 64 + c0 + 1] = h[1]; }
    }
#undef LRU_PREFETCH
    asm volatile("s_waitcnt vmcnt(0) lgkmcnt(0)" ::: "memory");
    __syncthreads();
}
}

typedef __attribute__((address_space(1))) unsigned gu32;
#define RLX_AGENT __ATOMIC_RELAXED, __HIP_MEMORY_SCOPE_AGENT
constexpr int LDSCTL_OFF = 131072, MISC_OFF = LDSCTL_OFF + 320;
constexpr int CW_BAR = 4096, CW_QUEUE = 8192;
#define XB_TMO      128
#define XB_XCNT(j)  (256  + 64 * (j))
#define XB_XSUB(j)  (1280 + 64 * (j))
#define XB_XGEN(j)  (2304 + 64 * (j))
#define XB_TOP      3328
#define XB_TOPGEN   3392
#define XCD_BAR_WORDS 3456
#define XB_SPIN_CAP (1u << 22)
__device__ __forceinline__ unsigned xb_ld(unsigned* p)              { return __hip_atomic_load(p, __ATOMIC_RELAXED, __HIP_MEMORY_SCOPE_AGENT); }
__device__ __forceinline__ unsigned xb_add(unsigned* p, unsigned v) { return __hip_atomic_fetch_add(p, v, __ATOMIC_RELAXED, __HIP_MEMORY_SCOPE_AGENT); }
__device__ __forceinline__ unsigned xb_xcc_id() { return (unsigned)__builtin_amdgcn_s_getreg((3 << 11) | 20) & 0xFu; }
#define XB_SPIN(cond, bar) do { unsigned _sp = 0; while (cond) { __builtin_amdgcn_s_sleep(1); \
    if ((++_sp & 255u) == 0u) { if (xb_ld(&(bar)[XB_TMO])) break; if (_sp > XB_SPIN_CAP) { atomicAdd(&(bar)[XB_TMO], 1u); break; } } } } while (0)
struct XcdBarrier { unsigned* bar; unsigned x; volatile LAS unsigned* st; };
__device__ __forceinline__ XcdBarrier xcd_barrier_post(unsigned* bar, volatile LAS unsigned* st) {
    XcdBarrier b; b.bar = bar; b.x = xb_xcc_id(); b.st = st;
    if (threadIdx.x == 0) (void)xb_add(&bar[XB_XCNT(b.x)], 1u);
    return b;
}
__device__ __forceinline__ void xcd_barrier_complete(unsigned* bar, unsigned x, unsigned& nloc, unsigned& nx) {
    const unsigned G = gridDim.x * gridDim.y * gridDim.z;
    unsigned sum, cnt, mine, sp = 0u;
    for (;;) {
        sum = 0u; cnt = 0u; mine = 0u;
#pragma unroll
        for (unsigned j = 0; j < 16; ++j) { const unsigned c = xb_ld(&bar[XB_XCNT(j)]); sum += c; cnt += (c > 0u) ? 1u : 0u; mine = (j == x) ? c : mine; }
        if (sum == G) break;
        __builtin_amdgcn_s_sleep(1);
        if ((++sp & 255u) == 0u) { if (xb_ld(&bar[XB_TMO])) break; if (sp > XB_SPIN_CAP) { atomicAdd(&bar[XB_TMO], 1u); break; } }
    }
    nloc = mine > 0u ? mine : 1u; nx = cnt > 0u ? cnt : 1u;
}
__device__ __forceinline__ void xcd_barrier(const XcdBarrier& b) {
    asm volatile("s_waitcnt vmcnt(0)" ::: "memory");
    __syncthreads();
    if (threadIdx.x == 0) {
        unsigned* bar = b.bar;
        __builtin_amdgcn_s_waitcnt(0);
        unsigned nloc = b.st[0], nx = b.st[1];
        if (nloc == 0u) { xcd_barrier_complete(bar, b.x, nloc, nx); b.st[0] = nloc; b.st[1] = nx; }
        const unsigned old = xb_add(&bar[XB_XSUB(b.x)], 1u);
        const unsigned gen = old / nloc;
        if (old + 1u == (gen + 1u) * nloc) {
            __builtin_amdgcn_fence(__ATOMIC_RELEASE, "agent");
            asm volatile("s_waitcnt vmcnt(0)" ::: "memory");
            const unsigned og = xb_add(&bar[XB_TOP], 1u);
            const unsigned tg = og / nx;
            if (og + 1u == (tg + 1u) * nx) xb_add(&bar[XB_TOPGEN], 1u);
            else XB_SPIN(xb_ld(&bar[XB_TOPGEN]) == tg, bar);
            __builtin_amdgcn_fence(__ATOMIC_ACQUIRE, "agent");
            xb_add(&bar[XB_XGEN(b.x)], 1u);
            asm volatile("s_waitcnt vmcnt(0)" ::: "memory");
        } else {
            XB_SPIN(xb_ld(&bar[XB_XGEN(b.x)]) == gen, bar);
            __builtin_amdgcn_fence(__ATOMIC_ACQUIRE, "agent");
            asm volatile("s_waitcnt vmcnt(0)" ::: "memory");
        }
    }
    __syncthreads();
}

#ifndef PH_MASK
#define PH_MASK 0x7f
#endif
#ifndef PROBE
#define PROBE 0
#endif
struct Args { const float* in[22]; float* out; unsigned char* ws; };

__device__ __forceinline__ void transpose_item(const float* __restrict__ W, int K, int N, int k0, int n0, bf16_t* WT, int drow0, const float* __restrict__ ksc, float csc, LAS float* scr, int lane) {
#pragma unroll 8
    for (int i = 0; i < 32; ++i) { const int kk = 2 * i + (lane >> 5); const float s = (ksc ? ksc[k0 + kk] : 1.0f) * csc; scr[kk * 33 + (lane & 31)] = W[(size_t)(k0 + kk) * N + n0 + (lane & 31)] * s; }
    asm volatile("s_waitcnt lgkmcnt(0)" ::: "memory");
    const int c = lane & 7;
#pragma unroll
    for (int j = 0; j < 4; ++j) { const int n = (lane >> 3) + 8 * j; const LAS float* s = scr + (8 * c) * 33 + n;
        u32x4 o; o.x = cvt_pk_bf16(s[0 * 33], s[1 * 33]); o.y = cvt_pk_bf16(s[2 * 33], s[3 * 33]); o.z = cvt_pk_bf16(s[4 * 33], s[5 * 33]); o.w = cvt_pk_bf16(s[6 * 33], s[7 * 33]);
        *(u32x4*)(WT + (size_t)(drow0 + n) * K + k0 + 8 * c) = o; }
    asm volatile("s_waitcnt lgkmcnt(0)" ::: "memory");
}

__global__ void __launch_bounds__(NTHREADS, 2) mega_fwd(Args args) {
    extern __shared__ __attribute__((aligned(16))) unsigned char lds[];
    cg::grid_group grid = cg::this_grid();
    const int tid = threadIdx.x, lane = tid & 63, wave = __builtin_amdgcn_readfirstlane(tid >> 6);
    const int G = gridDim.x, bx = blockIdx.x;
    const int vcu = (G % 8 == 0) ? (bx % 8) * (G / 8) + bx / 8 : bx;
    unsigned char* ws = args.ws;
    const float* x_p = args.in[0]; const float* x_s = args.in[1];
    bf16_t* Win_t = (bf16_t*)(ws + WS_WIN); bf16_t* Wout_t = (bf16_t*)(ws + WS_WOUT); bf16_t* Wgu_t = (bf16_t*)(ws + WS_WGU); bf16_t* Wdn_t = (bf16_t*)(ws + WS_WDN);
    float* SSQ = (float*)(ws + WS_SSQ); bf16_t* XN = (bf16_t*)(ws + WS_XN); bf16_t* HF = (bf16_t*)(ws + WS_HF); float* STASH = (float*)(ws + WS_STASH);
    bf16_t* PROJ = (bf16_t*)(ws + WS_PROJ); bf16_t* HB = (bf16_t*)(ws + WS_H);
    float* out = args.out;
    const int gw = vcu * NWAVES + wave, NGW = G * NWAVES;
    unsigned* ctl = (unsigned*)(ws + WS_CTL);
    for (int u = tid; u < (LDS_BYTES - LDSCTL_OFF) / 4; u += NTHREADS) ((LAS unsigned*)((LAS unsigned char*)lds + LDSCTL_OFF))[u] = 0u;
    __syncthreads();
    volatile LAS unsigned* MISC = (volatile LAS unsigned*)((LAS unsigned char*)lds + MISC_OFF);
    const XcdBarrier xbar = xcd_barrier_post(ctl + CW_BAR, MISC + 8);

    if (PH_MASK & 1) {
        LAS float* scr = (LAS float*)((LAS unsigned char*)lds + wave * 16384);
        constexpr int I_IN = 16 * 80, I_OUT = 16 * 32, I_G = 16 * 88, I_U = 16 * 88, I_D = 44 * 32;
        constexpr int NITEMS = I_IN + I_OUT + I_G + I_U + I_D;
        for (int it = gw; it < NITEMS; it += NGW) {
            int r = it;
            if (r < I_IN) { const int kb = r / 80, nb = r % 80, n0 = nb * 32, reg = n0 >> 9, off = n0 & 511;
                const int dbase = reg == 0 ? COL_Q : reg == 1 ? COL_K : reg == 2 ? COL_V : reg == 3 ? COL_XR : COL_G;
                transpose_item(args.in[3], DM, NPROJ, kb * 64, n0, Win_t, dbase + off, nullptr, reg == 0 ? QSCALE : 1.0f, scr, lane); continue; } r -= I_IN;
            if (r < I_OUT) { const int kb = r / 32, nb = r % 32; transpose_item(args.in[16], DM, DM, kb * 64, nb * 32, Wout_t, nb * 32, nullptr, 1.0f, scr, lane); continue; } r -= I_OUT;
            if (r < I_G) { const int kb = r / 88, nb = r % 88, n0 = nb * 32; transpose_item(args.in[18], DM, DFF, kb * 64, n0, Wgu_t, 256 * (n0 >> 7) + (n0 & 127), args.in[17], 1.0f, scr, lane); continue; } r -= I_G;
            if (r < I_U) { const int kb = r / 88, nb = r % 88, n0 = nb * 32; transpose_item(args.in[19], DM, DFF, kb * 64, n0, Wgu_t, 256 * (n0 >> 7) + 128 + (n0 & 127), args.in[17], 1.0f, scr, lane); continue; } r -= I_U;
            { const int kb = r / 32, nb = r % 32; transpose_item(args.in[20], DFF, DM, kb * 64, nb * 32, Wdn_t, nb * 32, nullptr, 1.0f, scr, lane); }
        }
        const f32x4* g4 = (const f32x4*)args.in[2];
        for (int m = gw; m < MTOK; m += NGW) {
            const float* xrow = (m < PROMPT_ROWS) ? x_p + (size_t)m * DM : x_s + (size_t)(m - PROMPT_ROWS) * DM;
            const f32x4* xr = (const f32x4*)xrow + lane; f32x4 v[4]; float s = 0.f;
#pragma unroll
            for (int j = 0; j < 4; ++j) { v[j] = xr[64 * j]; s += (v[j].x * v[j].x + v[j].y * v[j].y) + (v[j].z * v[j].z + v[j].w * v[j].w); }
            const float rstd = __builtin_amdgcn_rsqf(wave_sum(s) * (1.0f / DM) + EPS);
            u32x2* o8 = (u32x2*)(XN + (size_t)m * DM) + lane;
#pragma unroll
            for (int j = 0; j < 4; ++j) { const f32x4 gg = g4[lane + 64 * j]; u32x2 w; w.x = cvt_pk_bf16(v[j].x * rstd * gg.x, v[j].y * rstd * gg.y); w.y = cvt_pk_bf16(v[j].z * rstd * gg.z, v[j].w * rstd * gg.w); o8[64 * j] = w; }
        }
    }
    grid.sync();

    if (PH_MASK & 2) { pg8::Gemm g{XN, Win_t, DM, MTOK, NPROJ, DM}; pg8::StaticOrder S; S.init(MTOK, NPROJ, G, bx);
      pg8::EpiStoreBf16 E{PROJ, NPROJ};
      pg8::gemm_phase(( LAS unsigned char*)lds, g, S, E);
      if (PROBE == 1) { __syncthreads(); pg8::gemm_phase(( LAS unsigned char*)lds, g, S, E); } }
    xcd_barrier(xbar);

    if (PH_MASK & 4) {
        float lam;
        { float s1 = 0.f, s2 = 0.f;
          for (int i = 0; i < 64; ++i) { s1 += args.in[11][i] * args.in[12][i]; s2 += args.in[13][i] * args.in[14][i]; }
          lam = expf(s1) - expf(s2) + 0.2f; }
        float* stash = STASH + (size_t)bx * 256 * 128;
        constexpr int L_AS = 64, L_LS = 8, L_AP = 64, L_LP = 16, L_TOT = L_AS + L_LS + L_AP + L_LP;
        unsigned qcur = xbar.x & 7u, qtried = 0u;
        for (;;) {
            if (tid == 0) { unsigned idx = 0u;
                while (qtried < 8u) { idx = xb_add(ctl + CW_QUEUE + 64 * qcur, 1u); if (idx < (unsigned)L_TOT) break; qcur = (qcur + 1u) & 7u; ++qtried; }
                MISC[16] = (qtried < 8u) ? (qcur * 256u + idx) : 0xffffffffu; }
            __syncthreads();
            const unsigned uv = MISC[16];
            __syncthreads();
            if (uv == 0xffffffffu) break;
            const int lx = (int)(uv >> 8), li = (int)(uv & 255u);
            if (li < L_AS || (li >= L_AS + L_LS && li < L_AS + L_LS + L_AP)) {
#ifndef NO_ATT
                int s, h, qb, S;
                if (li < L_AS) { const int pair = 4 * lx + (li >> 4); s = 16 + (pair >> 2); h = pair & 3; qb = li & 15; S = S_S; }
                else { const int l2 = li - (L_AS + L_LS), pair = 8 * lx + (l2 >> 3); s = pair >> 2; h = pair & 3; qb = l2 & 7; S = S_P; }
                const long R0 = (s < 16) ? (long)s * S_P : (long)PROMPT_ROWS + (long)(s - 16) * S_S;
                const float mp = exp2f(-2.0f * (float)(h + 1)) * LOG2E;
                bf16_t* base = PROJ + R0 * NPROJ;
                bf16_t* Qb = base + (long)(qb * 256) * NPROJ + COL_Q + h * 128;
                const bf16_t* Kh = base + COL_K + h * 128; const bf16_t* Vh = base + COL_V + h * 128;
                const int NT = S / 64, t0 = qb * 4;
                if (PROBE == 2) { bf16_t* dry = (bf16_t*)(ws + 128 * MiB) + (size_t)bx * 256 * 128;
                    att::attn_pass<0>(Qb, Kh, Vh, NT, t0, qb * 256, mp, lam, args.in[15], stash, dry, 128, (char*)lds);
                    att::attn_pass<1>(Qb + 64, Kh + 64, Vh, NT, t0, qb * 256, mp, lam, args.in[15], stash, dry, 128, (char*)lds); }
                att::attn_pass<0>(Qb, Kh, Vh, NT, t0, qb * 256, mp, lam, args.in[15], stash, Qb, NPROJ, (char*)lds);
                att::attn_pass<1>(Qb + 64, Kh + 64, Vh, NT, t0, qb * 256, mp, lam, args.in[15], stash, Qb, NPROJ, (char*)lds);
#endif
            } else {
#ifndef NO_LRU
                int s, n, S;
                if (li < L_AS + L_LS) { s = 16 + lx; n = li - L_AS; S = S_S; }
                else { const int l2 = li - (L_AS + L_LS + L_AP); s = 2 * lx + (l2 >> 3); n = l2 & 7; S = S_P; }
                const long R0 = (s < 16) ? (long)s * S_P : (long)PROMPT_ROWS + (long)(s - 16) * S_S;
                if (PROBE == 3) {
                    lru::lru_dir<0, true>(PROJ, HF, R0, S, n, args.in[4], args.in[5], args.in[6], args.in[7], args.in[8], args.in[9], args.in[10], (char*)lds);
                    lru::lru_dir<1, true>(PROJ, HF, R0, S, n, args.in[4], args.in[5], args.in[6], args.in[7], args.in[8], args.in[9], args.in[10], (char*)lds); }
                lru::lru_dir<0>(PROJ, HF, R0, S, n, args.in[4], args.in[5], args.in[6], args.in[7], args.in[8], args.in[9], args.in[10], (char*)lds);
                lru::lru_dir<1>(PROJ, HF, R0, S, n, args.in[4], args.in[5], args.in[6], args.in[7], args.in[8], args.in[9], args.in[10], (char*)lds);
#endif
            }
        }
    }
    xcd_barrier(xbar);

    if (PH_MASK & 8) { pg8::Gemm g{PROJ, Wout_t, NPROJ, MTOK, DM, DM}; pg8::StaticOrder S; S.init(MTOK, DM, G, bx);
      pg8::EpiResid<true> E{x_p, x_s, out, XN, SSQ};
      pg8::gemm_phase((LAS unsigned char*)lds, g, S, E); }
    xcd_barrier(xbar);

    if (PH_MASK & 16) { pg8::Gemm g{XN, Wgu_t, DM, MTOK, NGU, DM}; pg8::StaticOrder S; S.init(MTOK, NGU, G, bx);
      pg8::EpiSwiGLU E{SSQ, HB};
      pg8::gemm_phase((LAS unsigned char*)lds, g, S, E);
      if (PROBE == 1) { __syncthreads(); pg8::gemm_phase((LAS unsigned char*)lds, g, S, E); } }
    xcd_barrier(xbar);

    if (PH_MASK & 32) { pg8::Gemm g{HB, Wdn_t, DFF, MTOK, DM, DFF}; pg8::StaticOrder S; S.init(MTOK, DM, G, bx);
      pg8::EpiResid<false> E{out, out + (size_t)PROMPT_ROWS * DM, out, nullptr, SSQ};
      pg8::gemm_phase((LAS unsigned char*)lds, g, S, E); }
    xcd_barrier(xbar);

    if (PH_MASK & 64) {
        const f32x4* g4 = (const f32x4*)args.in[21];
        for (int m = gw; m < MTOK; m += NGW) {
            float sv = (lane < 16) ? SSQ[(size_t)m * 16 + lane] : 0.f;
            sv += __shfl_xor(sv, 1); sv += __shfl_xor(sv, 2); sv += __shfl_xor(sv, 4); sv += __shfl_xor(sv, 8);
            const float tot = __shfl(sv, 0);
            const float rstd = __builtin_amdgcn_rsqf(tot * (1.0f / DM) + EPS);
            f32x4* xr = (f32x4*)(out + (size_t)m * DM) + lane;
#pragma unroll
            for (int j = 0; j < 4; ++j) { const f32x4 gg = g4[lane + 64 * j]; f32x4 v = xr[64 * j]; v.x *= rstd * gg.x; v.y *= rstd * gg.y; v.z *= rstd * gg.z; v.w *= rstd * gg.w; xr[64 * j] = v; }
        }
    }
}

extern "C" void kernel_launch(void* const* d_in, const int* in_sizes, int n_in, void* d_out, int out_size, void* d_ws, size_t ws_size, hipStream_t stream) {
    static int grid_blocks = 0;
    if (grid_blocks == 0) {
        if (n_in != 22 || in_sizes[0] != PROMPT_ROWS * DM || in_sizes[1] != PROMPT_ROWS * DM || out_size != MTOK * DM || ws_size < WS_END) {
            fprintf(stderr, "kernel_launch: shape mismatch (n_in %d, in0 %d, out %d, ws %zu)\n", n_in, n_in > 0 ? in_sizes[0] : -1, out_size, ws_size); grid_blocks = -1; return; }
        int dev = 0, cus = 0, per_cu = 0;
        (void)hipGetDevice(&dev);
        (void)hipDeviceGetAttribute(&cus, hipDeviceAttributeMultiprocessorCount, dev);
        if (hipFuncSetAttribute((const void*)mega_fwd, hipFuncAttributeMaxDynamicSharedMemorySize, LDS_BYTES) != hipSuccess) { fprintf(stderr, "kernel_launch: hipFuncSetAttribute failed\n"); grid_blocks = -1; return; }
        if (hipOccupancyMaxActiveBlocksPerMultiprocessor(&per_cu, (const void*)mega_fwd, NTHREADS, LDS_BYTES) != hipSuccess || per_cu < 1) { fprintf(stderr, "kernel_launch: occupancy query failed (%d)\n", per_cu); grid_blocks = -1; return; }
        grid_blocks = cus * 1;
    }
    if (grid_blocks < 0) return;
    if (hipMemsetAsync((char*)d_ws + WS_CTL, 0, CTL_BYTES, stream) != hipSuccess) { fprintf(stderr, "kernel_launch: hipMemsetAsync failed\n"); return; }
    Args a{};
    for (int i = 0; i < 22; ++i) a.in[i] = (const float*)d_in[i];
    a.out = (float*)d_out; a.ws = (unsigned char*)d_ws;
    void* kargs[] = {&a};
    hipError_t e = hipLaunchCooperativeKernel((const void*)mega_fwd, dim3(grid_blocks), dim3(NTHREADS), kargs, LDS_BYTES, stream);
    if (e != hipSuccess) fprintf(stderr, "kernel_launch: cooperative launch failed: %s (grid %d)\n", hipGetErrorString(e), grid_blocks);
}
```

```cpp
#include <hip/hip_runtime.h>
#include <hip/hip_cooperative_groups.h>
#include <cstdio>
#include <cstdint>
namespace cg = cooperative_groups;

#define LAS __attribute__((address_space(3)))
typedef unsigned short bf16_t;
typedef short bf16x8 __attribute__((ext_vector_type(8)));
typedef short s16x4 __attribute__((ext_vector_type(4)));
typedef float f32x2 __attribute__((ext_vector_type(2)));
typedef float f32x4 __attribute__((ext_vector_type(4)));
typedef float f32x16 __attribute__((ext_vector_type(16)));
typedef unsigned u32x2 __attribute__((ext_vector_type(2)));
typedef unsigned u32x4 __attribute__((ext_vector_type(4)));

constexpr int DM = 1024, MTOK = 65536, NPROJ = 2560, DFF = 2816, NGU = 2 * DFF;
constexpr int PROMPT_ROWS = 32768, S_P = 2048, S_S = 4096;
constexpr int COL_Q = 0, COL_G = 512, COL_K = 1024, COL_V = 1536, COL_XR = 2048;
constexpr float EPS = 1e-6f;
constexpr float LOG2E = 1.4426950408889634f;
constexpr float QSCALE = 0.125f * LOG2E;
constexpr int NWAVES = 8, NTHREADS = 512;

constexpr size_t MiB = 1u << 20;
constexpr size_t WS_CTL = 0, CTL_BYTES = 65536;
constexpr size_t WS_WIN = 1 * MiB, WS_WOUT = 6 * MiB, WS_WGU = 8 * MiB, WS_WDN = 19 * MiB;
constexpr size_t WS_SSQ = 25 * MiB;
constexpr size_t WS_XN = 32 * MiB;
constexpr size_t WS_HF = 32 * MiB;
constexpr size_t WS_STASH = 96 * MiB;
constexpr size_t WS_PROJ = 160 * MiB;
constexpr size_t WS_H = 160 * MiB;
constexpr size_t WS_END = 512 * MiB;

constexpr int LDS_BYTES = 147456;

__device__ __forceinline__ unsigned cvt_pk_bf16(float lo, float hi) { unsigned r; asm volatile("v_cvt_pk_bf16_f32 %0, %1, %2" : "=v"(r) : "v"(lo), "v"(hi)); return r; }
__device__ __forceinline__ float bf16lo(unsigned u) { return __uint_as_float(u << 16); }
__device__ __forceinline__ float bf16hi(unsigned u) { return __uint_as_float(u & 0xffff0000u); }
__device__ __forceinline__ float wave_sum(float v) {
#pragma unroll
    for (int o = 1; o < 64; o <<= 1) v += __shfl_xor(v, o);
    return v;
}
__device__ __forceinline__ float fast_sigmoid(float x) { return __builtin_amdgcn_rcpf(1.0f + __builtin_amdgcn_exp2f(-LOG2E * x)); }

namespace pg8 {
constexpr int BM = 256, BK = 64, HALF = 128, HTB = HALF * BK * 2, STAGE_BYTES = 8 * HTB, NXCD = 8, WGM = 8;
__host__ __device__ __forceinline__ int lds_byte(int r, int c) { const int st = (r >> 4) * 2 + (c >> 5), rr = r & 15, cc = c & 31, ob = rr * 64 + cc * 2; return st * 1024 + (ob ^ (((ob >> 9) & 1) << 5)); }
__host__ __device__ __forceinline__ void stage_rc(int b, int& R, int& C) { const int st = b / 1024, sb = b % 1024, swz = sb ^ (((sb >> 9) & 1) << 5); R = (st >> 1) * 16 + swz / 64; C = (st & 1) * 32 + (swz % 64) / 2; }
__host__ __device__ __forceinline__ int perm32(int rho) { const int n = rho >> 4, i = rho & 15; return 8 * (i >> 2) + 4 * n + (i & 3); }

struct Unit { int pm, pn; };
struct Gemm { const bf16_t* A; const bf16_t* Bt; int lda; int M, N, K; };

struct StaticOrder {
    int nM, nN, nwg, G, c;
    __device__ void init(int M, int N, int G_, int c_) { nM = M / BM; nN = N / BM; nwg = nM * nN; G = G_; c = c_; }
    __device__ bool next(int i, Unit& u) const {
        const long L = (long)i * G + c; if (L >= nwg) return false;
        int wgid = (int)L; { const int q = nwg / NXCD, r = nwg % NXCD, xcd = wgid % NXCD, off = wgid / NXCD; wgid = (xcd < r ? xcd * (q + 1) : r * (q + 1) + (xcd - r) * q) + off; }
        const int nig = WGM * nN, gid = wgid / nig, fm = gid * WGM, gsz = (nM - fm) < WGM ? (nM - fm) : WGM;
        u.pm = fm + ((wgid % nig) % gsz); u.pn = (wgid % nig) / gsz; return true;
    }
};


struct EpiStoreBf16 {
    bf16_t* O; int ldc;
    __device__ __forceinline__ void operator()(const f32x4 (&acc)[2][2][4][2], const Unit& u, int wr, int wc, int fr, int fq) const {
        const int row0 = u.pm * BM + wr * 64 + fr, col0 = u.pn * BM + wc * 32 + 8 * fq;
#pragma unroll
        for (int ai = 0; ai < 2; ++ai)
#pragma unroll
            for (int m = 0; m < 4; ++m) { bf16_t* rowp = O + (size_t)(row0 + ai * HALF + m * 16) * ldc + col0;
#pragma unroll
                for (int bj = 0; bj < 2; ++bj) { const f32x4 v0 = acc[ai][bj][m][0], v1 = acc[ai][bj][m][1];
                    u32x4 w; w.x = cvt_pk_bf16(v0[0], v0[1]); w.y = cvt_pk_bf16(v0[2], v0[3]); w.z = cvt_pk_bf16(v1[0], v1[1]); w.w = cvt_pk_bf16(v1[2], v1[3]);
                    *(u32x4*)(rowp + bj * HALF) = w; } }
    }
};
template <bool WRITE_BF16> struct EpiResid {
    const float* r0; const float* r1;
    float* out; bf16_t* xn; float* ssq;
    __device__ __forceinline__ void operator()(const f32x4 (&acc)[2][2][4][2], const Unit& u, int wr, int wc, int fr, int fq) const {
        const int row0 = u.pm * BM + wr * 64 + fr, col0 = u.pn * BM + wc * 32 + 8 * fq;
        const float* rbase = (row0 < PROMPT_ROWS) ? r0 : (r1 - (size_t)PROMPT_ROWS * DM);
#pragma unroll
        for (int ai = 0; ai < 2; ++ai)
#pragma unroll
            for (int m = 0; m < 4; ++m) { const int row = row0 + ai * HALF + m * 16; const float* rp = rbase + (size_t)row * DM + col0; float* op = out + (size_t)row * DM + col0;
                float ss = 0.f;
#pragma unroll
                for (int bj = 0; bj < 2; ++bj) { const f32x4 a0 = *(const f32x4*)(rp + bj * HALF), a1 = *(const f32x4*)(rp + bj * HALF + 4);
                    const f32x4 v0 = acc[ai][bj][m][0] + a0, v1 = acc[ai][bj][m][1] + a1;
                    ss += (v0[0] * v0[0] + v0[1] * v0[1]) + (v0[2] * v0[2] + v0[3] * v0[3]); ss += (v1[0] * v1[0] + v1[1] * v1[1]) + (v1[2] * v1[2] + v1[3] * v1[3]);
                    *(f32x4*)(op + bj * HALF) = v0; *(f32x4*)(op + bj * HALF + 4) = v1;
                    if (WRITE_BF16) { u32x4 w; w.x = cvt_pk_bf16(v0[0], v0[1]); w.y = cvt_pk_bf16(v0[2], v0[3]); w.z = cvt_pk_bf16(v1[0], v1[1]); w.w = cvt_pk_bf16(v1[2], v1[3]);
                        *(u32x4*)(xn + (size_t)row * DM + col0 + bj * HALF) = w; } }
                ss += __shfl_xor(ss, 16); ss += __shfl_xor(ss, 32);
                if (fq == 0) ssq[(size_t)row * 16 + u.pn * 4 + wc] = ss; }
    }
};
struct EpiSwiGLU {
    const float* ssq; bf16_t* H;
    __device__ __forceinline__ void operator()(const f32x4 (&acc)[2][2][4][2], const Unit& u, int wr, int wc, int fr, int fq) const {
        const int row0 = u.pm * BM + wr * 64 + fr, col0 = u.pn * HALF + wc * 32 + 8 * fq;
#pragma unroll
        for (int ai = 0; ai < 2; ++ai)
#pragma unroll
            for (int m = 0; m < 4; ++m) { const int row = row0 + ai * HALF + m * 16;
                const f32x4* sp = (const f32x4*)(ssq + (size_t)row * 16); const f32x4 s0 = sp[0], s1 = sp[1], s2 = sp[2], s3 = sp[3];
                const f32x4 st = (s0 + s1) + (s2 + s3); const float tot = (st[0] + st[1]) + (st[2] + st[3]);
                const float rstd = __builtin_amdgcn_rsqf(tot * (1.0f / DM) + EPS);
                float o[8];
#pragma unroll
                for (int n = 0; n < 2; ++n)
#pragma unroll
                    for (int e = 0; e < 4; ++e) { const float g = acc[ai][0][m][n][e] * rstd, up = acc[ai][1][m][n][e] * rstd; o[n * 4 + e] = g * up * fast_sigmoid(g); }
                u32x4 w; w.x = cvt_pk_bf16(o[0], o[1]); w.y = cvt_pk_bf16(o[2], o[3]); w.z = cvt_pk_bf16(o[4], o[5]); w.w = cvt_pk_bf16(o[6], o[7]);
                *(u32x4*)(H + (size_t)row * DFF + col0) = w; }
    }
};

template <class Epi>
__device__ __forceinline__ void gemm_phase(LAS unsigned char* lds, const Gemm g, const StaticOrder& S, const Epi& E) {
    int tid = threadIdx.x; asm volatile("" : "+v"(tid));
    const int wid = __builtin_amdgcn_readfirstlane(tid >> 6), lane = tid & 63, wr = wid >> 2, wc = wid & 3, fr = lane & 15, fq = lane >> 4;
    const int K = g.K, nt = K / BK, lda = g.lda;
    unsigned voffA[2], voffB[2];
#pragma unroll
    for (int i = 0; i < 2; ++i) { int R, C; stage_rc(tid * 16 + i * 8192, R, C); const int Rb = (R & ~31) + perm32(R & 31);
        voffA[i] = (unsigned)(R * lda + C) * 2u; voffB[i] = (unsigned)(Rb * K + C) * 2u; }
    const size_t kstep = (size_t)(BK * 2);
    const size_t hstepA = (size_t)HALF * lda * 2, hstepB = (size_t)HALF * K * 2;
    const size_t tstepA = 2 * hstepA, tstepB = 2 * hstepB;
    const unsigned ldsw = (unsigned)wid * 1024u;
    const int aoff = lds_byte(wr * 64 + fr, fq * 8), boff = lds_byte(wc * 32 + fr, fq * 8);
#define PG8_SA(b, h) (((b) * 2 + (h)) * HTB)
#define PG8_SB(b, h) ((4 + (b) * 2 + (h)) * HTB)
#define PG8_STAGE(bufoff, gbase, voff) do { _Pragma("unroll") for (int _i = 0; _i < 2; ++_i) \
        __builtin_amdgcn_global_load_lds((const unsigned*)((const char*)(gbase) + (voff)[_i]), (LAS unsigned*)(lds + (bufoff) + ldsw + _i * 8192), 16, 0, 0); } while (0)
#define PG8_LDA(dst, b, h) do { _Pragma("unroll") for (int m = 0; m < 4; ++m) _Pragma("unroll") for (int k = 0; k < 2; ++k) dst[m][k] = *(const LAS bf16x8*)(lds + PG8_SA(b, h) + aoff + m * 2048 + k * 1024); } while (0)
#define PG8_LDB(dst, b, h) do { _Pragma("unroll") for (int n = 0; n < 2; ++n) _Pragma("unroll") for (int k = 0; k < 2; ++k) dst[n][k] = *(const LAS bf16x8*)(lds + PG8_SB(b, h) + boff + n * 2048 + k * 1024); } while (0)
#define PG8_MMA(ai, bj, At, Bt) do { __builtin_amdgcn_s_setprio(1); _Pragma("unroll") for (int m = 0; m < 4; ++m) _Pragma("unroll") for (int n = 0; n < 2; ++n) _Pragma("unroll") for (int k = 0; k < 2; ++k) \
        acc[ai][bj][m][n] = __builtin_amdgcn_mfma_f32_16x16x32_bf16(Bt[n][k], At[m][k], acc[ai][bj][m][n], 0, 0, 0); __builtin_amdgcn_s_setprio(0); } while (0)
#define PG8_WAIT_V(n) asm volatile("s_waitcnt vmcnt(" #n ")" ::: "memory")
#define PG8_WAIT_L(n) asm volatile("s_waitcnt lgkmcnt(" #n ")" ::: "memory")
#define PG8_BAR __builtin_amdgcn_s_barrier()
#define PG8_SCHED __builtin_amdgcn_sched_barrier(0)
    Unit cur, nxt; int ui = 0;
    if (!S.next(0, cur)) return;
    f32x4 acc[2][2][4][2];
#pragma unroll
    for (int a = 0; a < 2; ++a)
#pragma unroll
        for (int b = 0; b < 2; ++b)
#pragma unroll
            for (int m = 0; m < 4; ++m)
#pragma unroll
                for (int n = 0; n < 2; ++n) acc[a][b][m][n] = (f32x4){0.f, 0.f, 0.f, 0.f};
    bf16x8 At[4][2], B0[2][2], B1[2][2];
    const char* cA = (const char*)g.A + (size_t)cur.pm * tstepA; const char* cB = (const char*)g.Bt + (size_t)cur.pn * tstepB;
    PG8_STAGE(PG8_SB(0, 0), cB, voffB); PG8_STAGE(PG8_SB(0, 1), cB + hstepB, voffB); PG8_STAGE(PG8_SA(0, 0), cA, voffA); PG8_STAGE(PG8_SA(0, 1), cA + hstepA, voffA);
    if (wr == 1) PG8_BAR;
    PG8_WAIT_V(2); PG8_BAR;
    PG8_STAGE(PG8_SB(1, 0), cB + kstep, voffB); PG8_STAGE(PG8_SA(1, 0), cA + kstep, voffA); PG8_STAGE(PG8_SB(1, 1), cB + hstepB + kstep, voffB);
    PG8_WAIT_V(6); PG8_BAR;
    for (;;) {
        const bool has_next = S.next(ui + 1, nxt);
        const char* nA = has_next ? (const char*)g.A + (size_t)nxt.pm * tstepA : cA; const char* nB = has_next ? (const char*)g.Bt + (size_t)nxt.pn * tstepB : cB;
        for (int t = 0; t < nt; t += 2) {
            const bool last = (t == nt - 2);
            const char* a1 = cA + (size_t)(t + 1) * kstep;
            const char* a2 = last ? nA : cA + (size_t)(t + 2) * kstep; const char* b2 = last ? nB : cB + (size_t)(t + 2) * kstep;
            const char* a3 = a2 + kstep; const char* b3 = b2 + kstep;
            PG8_LDB(B0, 0, 0); PG8_LDB(B1, 0, 1); PG8_SCHED; PG8_LDA(At, 0, 0); PG8_STAGE(PG8_SA(1, 1), a1 + hstepA, voffA);
            PG8_WAIT_V(8); PG8_WAIT_L(0); PG8_BAR; PG8_MMA(0, 0, At, B0); PG8_MMA(0, 1, At, B1); PG8_BAR; PG8_SCHED;
            PG8_LDA(At, 0, 1); PG8_STAGE(PG8_SB(0, 0), b2, voffB); PG8_STAGE(PG8_SB(0, 1), b2 + hstepB, voffB); PG8_STAGE(PG8_SA(0, 0), a2, voffA);
            PG8_WAIT_V(8); PG8_WAIT_L(0); PG8_BAR; PG8_MMA(1, 0, At, B0); PG8_MMA(1, 1, At, B1); PG8_BAR; PG8_SCHED;
            PG8_LDB(B0, 1, 0); PG8_LDB(B1, 1, 1); PG8_SCHED; PG8_LDA(At, 1, 0); PG8_STAGE(PG8_SA(0, 1), a2 + hstepA, voffA);
            PG8_WAIT_V(8); PG8_WAIT_L(0); PG8_BAR; PG8_MMA(0, 0, At, B0); PG8_MMA(0, 1, At, B1); PG8_BAR; PG8_SCHED;
            PG8_LDA(At, 1, 1); PG8_STAGE(PG8_SB(1, 0), b3, voffB); PG8_STAGE(PG8_SB(1, 1), b3 + hstepB, voffB); PG8_STAGE(PG8_SA(1, 0), a3, voffA);
            PG8_WAIT_V(8); PG8_WAIT_L(0); PG8_BAR; PG8_MMA(1, 0, At, B0); PG8_MMA(1, 1, At, B1); PG8_BAR; PG8_SCHED;
        }
        if (wr == 0) PG8_BAR;
        E(acc, cur, wr, wc, fr, fq);
        if (!has_next) break;
#pragma unroll
        for (int a = 0; a < 2; ++a)
#pragma unroll
            for (int b = 0; b < 2; ++b)
#pragma unroll
                for (int m = 0; m < 4; ++m)
#pragma unroll
                    for (int n = 0; n < 2; ++n) acc[a][b][m][n] = (f32x4){0.f, 0.f, 0.f, 0.f};
        cur = nxt; cA = nA; cB = nB; ++ui;
        if (wr == 1) PG8_BAR;
    }
    PG8_WAIT_V(0);
    PG8_BAR;
#undef PG8_SA
#undef PG8_SB
#undef PG8_STAGE
#undef PG8_LDA
#undef PG8_LDB
#undef PG8_MMA
#undef PG8_WAIT_V
#undef PG8_WAIT_L
#undef PG8_BAR
#undef PG8_SCHED
}
}

namespace att {
constexpr int PITCH = NPROJ, QBLK = 32, KVBLK = 64;
constexpr int SHM_V = KVBLK * 128 * 2, SHM_K = KVBLK * 64 * 2, OFF_K = 2 * SHM_V, OFF_WS = OFF_K + 2 * SHM_K;
constexpr float THR = 8.f;
#define KSWZ64(row, cb) ((row) * 128 + ((cb) ^ ((((row) >> 1) & 7) << 4)))
#define SBAR() __builtin_amdgcn_sched_barrier(0)
__device__ __forceinline__ int crow(int r, int hi) { return (r & 3) + 8 * (r >> 2) + 4 * hi; }

__device__ __forceinline__ void cinit(f32x16& c0, f32x16& c1, int kind, float mp, float dj0, float mhat) {
    if (kind == 1) {
#pragma unroll
        for (int r = 0; r < 16; ++r) { const float c = (float)((r & 3) + 8 * (r >> 2));
            c0[r] = __builtin_fmaf(-mp, __builtin_fabsf(dj0 + c), -mhat); c1[r] = __builtin_fmaf(-mp, __builtin_fabsf(dj0 + (c + 32.f)), -mhat); }
    } else {
        const float smp = kind == 0 ? mp : -mp, B = __builtin_fmaf(smp, dj0, -mhat);
#pragma unroll
        for (int r = 0; r < 16; ++r) { const float c = (float)((r & 3) + 8 * (r >> 2));
            c0[r] = __builtin_fmaf(smp, c, B); c1[r] = __builtin_fmaf(smp, c + 32.f, B); }
    }
}
#define MX3(a, b, c) __builtin_fmaxf(__builtin_fmaxf((a), (b)), (c))
template <bool FIRST>
__device__ __forceinline__ void partialSM(f32x16& p0, f32x16& p1, float& mhat, float& alpha) {
    float a = MX3(p0[0], p0[1], p1[0]), b = MX3(p0[2], p0[3], p1[1]); a = MX3(a, p1[2], p1[3]);
#pragma unroll
    for (int r = 4; r < 16; r += 4) { a = MX3(a, p0[r], p0[r + 1]); b = MX3(b, p0[r + 2], p0[r + 3]); a = MX3(a, p1[r], p1[r + 1]); b = MX3(b, p1[r + 2], p1[r + 3]); }
    float rm = __builtin_fmaxf(a, b);
    { auto rr = __builtin_amdgcn_permlane32_swap(__float_as_uint(rm), __float_as_uint(rm), false, false);
      rm = __builtin_fmaxf(__uint_as_float(rr[0]), __uint_as_float(rr[1])); }
    alpha = 1.f;
    if (FIRST || __builtin_expect(__any(rm > THR), 0)) {
        const float dl = FIRST ? rm : __builtin_fmaxf(rm, 0.f); mhat += dl;
#pragma unroll
        for (int r = 0; r < 16; ++r) { p0[r] -= dl; p1[r] -= dl; }
        alpha = FIRST ? 1.f : __builtin_amdgcn_exp2f(-dl);
    }
#pragma unroll
    for (int r = 0; r < 16; ++r) p0[r] = __builtin_amdgcn_exp2f(p0[r]);
}
__device__ __forceinline__ void finishSM(f32x16& p0, f32x16& p1, float alpha, float& l_reg, bf16x8& pa0, bf16x8& pa1, bf16x8& pa2, bf16x8& pa3) {
#pragma unroll
    for (int r = 0; r < 16; ++r) p1[r] = __builtin_amdgcn_exp2f(p1[r]);
    float ps = 0;
#pragma unroll
    for (int r = 0; r < 16; ++r) ps += p0[r];
#pragma unroll
    for (int r = 0; r < 16; ++r) ps += p1[r];
    { auto rr = __builtin_amdgcn_permlane32_swap(__float_as_uint(ps), __float_as_uint(ps), false, false);
      ps = __uint_as_float(rr[0]) + __uint_as_float(rr[1]); }
    l_reg = l_reg * alpha + ps;
#define PK4(P, BASE, OUT) do { unsigned a0 = cvt_pk_bf16(P[BASE + 0], P[BASE + 1]), a1 = cvt_pk_bf16(P[BASE + 2], P[BASE + 3]);   \
    unsigned b0 = cvt_pk_bf16(P[BASE + 4], P[BASE + 5]), b1 = cvt_pk_bf16(P[BASE + 6], P[BASE + 7]);                              \
    auto r0 = __builtin_amdgcn_permlane32_swap(a0, b0, false, false); auto r1 = __builtin_amdgcn_permlane32_swap(a1, b1, false, false); \
    u32x4 w = {r0[0], r1[0], r0[1], r1[1]}; OUT = *reinterpret_cast<bf16x8*>(&w); } while (0)
    PK4(p0, 0, pa0); PK4(p0, 8, pa1); PK4(p1, 0, pa2); PK4(p1, 8, pa3);
#undef PK4
}
__device__ __forceinline__ void qkt(f32x16& p0, f32x16& p1, const char* Ks, const bf16x8* qr, int r32, int hi) {
#pragma unroll
    for (int d0 = 0; d0 < 4; ++d0) { const int cb = d0 * 32 + hi * 16;
        const bf16x8 b0 = *reinterpret_cast<const bf16x8*>(Ks + KSWZ64(r32, cb));
        const bf16x8 b1 = *reinterpret_cast<const bf16x8*>(Ks + KSWZ64(32 + r32, cb));
        p0 = __builtin_amdgcn_mfma_f32_32x32x16_bf16(b0, qr[d0], p0, 0, 0, 0);
        p1 = __builtin_amdgcn_mfma_f32_32x32x16_bf16(b1, qr[d0], p1, 0, 0, 0); }
}
__device__ __forceinline__ int v_st(int k, int c) { const int kk = (k & ~0xC) | ((k & 4) << 1) | ((k & 8) >> 1); return ((kk >> 3) * 4 + (c >> 5)) * 512 + ((kk & 7) * 32 + (c & 31)) * 2; }
__device__ __forceinline__ int v_rd_base(int lane) { return ((lane & 3) << 3) | (((lane >> 2) & 3) << 6) | (((lane >> 4) & 1) << 5) | (((lane >> 5) & 1) << 8); }
constexpr int v_rd_off(int d0, int ks, int half) { return d0 * 512 + ks * 4096 + half * 2048; }
template <int OFF> __device__ __forceinline__ s16x4 tr_read(int vb) {
    s16x4 r; asm volatile("ds_read_b64_tr_b16 %0, %1 offset:%2" : "=&v"(r) : "v"(vb), "i"(OFF) : "memory"); return r;
}
template <int D0> __device__ __forceinline__ void pv_one(f32x16& od, int vb, bf16x8 pa0, bf16x8 pa1, bf16x8 pa2, bf16x8 pa3) {
    const s16x4 l0 = tr_read<v_rd_off(D0, 0, 0)>(vb), h0 = tr_read<v_rd_off(D0, 0, 1)>(vb), l1 = tr_read<v_rd_off(D0, 1, 0)>(vb), h1 = tr_read<v_rd_off(D0, 1, 1)>(vb);
    const s16x4 l2 = tr_read<v_rd_off(D0, 2, 0)>(vb), h2 = tr_read<v_rd_off(D0, 2, 1)>(vb), l3 = tr_read<v_rd_off(D0, 3, 0)>(vb), h3 = tr_read<v_rd_off(D0, 3, 1)>(vb);
    asm volatile("s_waitcnt lgkmcnt(0)" ::: "memory"); SBAR();
#define PK(L, H) (bf16x8){L[0], L[1], L[2], L[3], H[0], H[1], H[2], H[3]}
    od = __builtin_amdgcn_mfma_f32_32x32x16_bf16(pa0, PK(l0, h0), od, 0, 0, 0);
    od = __builtin_amdgcn_mfma_f32_32x32x16_bf16(pa1, PK(l1, h1), od, 0, 0, 0);
    od = __builtin_amdgcn_mfma_f32_32x32x16_bf16(pa2, PK(l2, h2), od, 0, 0, 0);
    od = __builtin_amdgcn_mfma_f32_32x32x16_bf16(pa3, PK(l3, h3), od, 0, 0, 0);
#undef PK
}
__device__ __forceinline__ void pv_d0(f32x16* o, int vb, bf16x8 pa0, bf16x8 pa1, bf16x8 pa2, bf16x8 pa3) {
    pv_one<0>(o[0], vb, pa0, pa1, pa2, pa3); pv_one<1>(o[1], vb, pa0, pa1, pa2, pa3); pv_one<2>(o[2], vb, pa0, pa1, pa2, pa3); pv_one<3>(o[3], vb, pa0, pa1, pa2, pa3);
}

template <int PASS>
__device__ __forceinline__ void attn_pass(const bf16_t* __restrict__ Qb, const bf16_t* __restrict__ Kh, const bf16_t* __restrict__ Vh, int NT, int t0, int ipos0, float mp,
                                          float lam, const float* __restrict__ subg, float* stash, bf16_t* Ob, int opitch, char* lds) {
    int tid = threadIdx.x; asm volatile("" : "+v"(tid));
    const int wid = __builtin_amdgcn_readfirstlane(tid >> 6), lane = tid & 63, r32 = lane & 31, hi = lane >> 5;
    char* V_lds = lds; char* K_lds = lds + OFF_K;
    float* ws = (float*)(lds + OFF_WS) + wid * 64; float* li_l = ws; float* al_l = ws + 32;
    float mhat = 0.f, l_reg = 0; f32x16 o[4] = {}; bf16x8 qr[4];
    const bf16_t* Qw = Qb + (long)(wid * QBLK + r32) * PITCH + hi * 8;
#pragma unroll
    for (int d0 = 0; d0 < 4; ++d0) qr[d0] = *reinterpret_cast<const bf16x8*>(Qw + d0 * 16);
    const int sr = tid >> 4, sc = (tid & 15) * 8, vst0 = v_st(sr, sc), vst1 = v_st(32 + sr, sc);
    const int kr = tid >> 3, kc = (tid & 7) * 8, kst = KSWZ64(kr, kc * 2);
    const int vb0 = (int)(uintptr_t)V_lds + v_rd_base(lane);
    const int ipos = ipos0 + wid * QBLK + r32;
    const int tdiag = (ipos0 >> 6) + (wid >> 1);
    struct { bf16x8 vs0, vs1, ks0; } sr_[2];
#define TJ(j) ((t0 + (j)) & (NT - 1))
#define DJ0(j) ((float)(TJ(j) * KVBLK + 4 * hi - ipos))
#define CINIT(P0, P1, j) do { const int tj_ = TJ(j); cinit(P0, P1, tj_ == tdiag ? 1 : (tj_ < tdiag ? 0 : 2), mp, (float)(tj_ * KVBLK + 4 * hi - ipos), mhat); } while (0)
#define SLOAD(i, j) do { const long k0_ = (long)TJ(j) * KVBLK; sr_[i].vs0 = *reinterpret_cast<const bf16x8*>(&Vh[(k0_ + sr) * PITCH + sc]); \
    sr_[i].vs1 = *reinterpret_cast<const bf16x8*>(&Vh[(k0_ + 32 + sr) * PITCH + sc]); sr_[i].ks0 = *reinterpret_cast<const bf16x8*>(&Kh[(k0_ + kr) * PITCH + kc]); } while (0)
#define SWRITE(b, i) do { *(bf16x8*)(V_lds + (b) * SHM_V + vst0) = sr_[i].vs0; *(bf16x8*)(V_lds + (b) * SHM_V + vst1) = sr_[i].vs1; \
    *(bf16x8*)(K_lds + (b) * SHM_K + kst) = sr_[i].ks0; } while (0)
#define SWAIT() asm volatile("s_waitcnt vmcnt(3)" ::: "memory")
#define RESC(a) do { if (__any((a) < 1.f)) { if (hi == 0) al_l[r32] = (a); asm volatile("s_waitcnt lgkmcnt(0)" ::: "memory"); \
    _Pragma("unroll") for (int d = 0; d < 4; ++d) _Pragma("unroll") for (int r = 0; r < 16; ++r) o[d][r] *= al_l[crow(r, hi)]; } } while (0)
    f32x16 pA0, pA1, pB0, pB1; float alA, alB; bf16x8 pa0, pa1, pa2, pa3;
    constexpr int SE = 0, SO = 1;
    SLOAD(SE, 0); asm volatile("s_waitcnt vmcnt(0)" ::: "memory"); SWRITE(0, SE); __syncthreads();
    CINIT(pA0, pA1, 0); qkt(pA0, pA1, K_lds, qr, r32, hi); partialSM<true>(pA0, pA1, mhat, alA);
    SLOAD(SO, 1); if (2 < NT) SLOAD(SE, 2);
    SWAIT(); SWRITE(1, SO); __syncthreads();
    for (int j = 1; j + 1 < NT; j += 2) {
        SBAR(); CINIT(pB0, pB1, j); qkt(pB0, pB1, K_lds + SHM_K, qr, r32, hi);
        finishSM(pA0, pA1, alA, l_reg, pa0, pa1, pa2, pa3); SBAR();
        SLOAD(SO, j + 2); SBAR();
        pv_d0(o, vb0, pa0, pa1, pa2, pa3); partialSM<false>(pB0, pB1, mhat, alB);
        __syncthreads(); SWAIT(); SWRITE(0, SE);
        RESC(alB); __syncthreads();
        SBAR(); CINIT(pA0, pA1, j + 1); qkt(pA0, pA1, K_lds, qr, r32, hi);
        finishSM(pB0, pB1, alB, l_reg, pa0, pa1, pa2, pa3); SBAR();
        if (j + 3 < NT) SLOAD(SE, j + 3); SBAR();
        pv_d0(o, vb0 + SHM_V, pa0, pa1, pa2, pa3); partialSM<false>(pA0, pA1, mhat, alA);
        __syncthreads(); SWAIT(); SWRITE(1, SO);
        RESC(alA); __syncthreads();
    }
    SBAR(); CINIT(pB0, pB1, NT - 1); qkt(pB0, pB1, K_lds + SHM_K, qr, r32, hi);
    finishSM(pA0, pA1, alA, l_reg, pa0, pa1, pa2, pa3); SBAR();
    pv_d0(o, vb0, pa0, pa1, pa2, pa3); partialSM<false>(pB0, pB1, mhat, alB);
    __syncthreads(); RESC(alB);
    finishSM(pB0, pB1, alB, l_reg, pa0, pa1, pa2, pa3); SBAR();
    pv_d0(o, vb0 + SHM_V, pa0, pa1, pa2, pa3);
    if (hi == 0) li_l[r32] = l_reg; asm volatile("s_waitcnt lgkmcnt(0)" ::: "memory");
    float rli[16];
#pragma unroll
    for (int r = 0; r < 16; ++r) rli[r] = __builtin_amdgcn_rcpf(li_l[crow(r, hi)]);
    float* st = stash + (long)(wid * QBLK) * 128 + r32;
    if (PASS == 0) {
#pragma unroll
        for (int r = 0; r < 16; ++r) { const int orow = crow(r, hi);
#pragma unroll
            for (int d0 = 0; d0 < 4; ++d0) st[orow * 128 + d0 * 32] = o[d0][r] * rli[r]; }
    } else {
        float g8[4];
#pragma unroll
        for (int d0 = 0; d0 < 4; ++d0) g8[d0] = 0.8f * subg[d0 * 32 + r32];
        bf16_t* Ow = Ob + (long)(wid * QBLK) * opitch + r32;
#pragma unroll
        for (int r = 0; r < 16; ++r) { const int orow = crow(r, hi); float ss = 0.f;
#pragma unroll
            for (int d0 = 0; d0 < 4; ++d0) { const float dl = st[orow * 128 + d0 * 32] - lam * (o[d0][r] * rli[r]); o[d0][r] = dl; ss += dl * dl; }
            ss += __shfl_xor(ss, 1); ss += __shfl_xor(ss, 2); ss += __shfl_xor(ss, 4); ss += __shfl_xor(ss, 8); ss += __shfl_xor(ss, 16);
            const float rn = __builtin_amdgcn_rsqf(ss * (1.0f / 128.0f) + EPS);
#pragma unroll
            for (int d0 = 0; d0 < 4; ++d0) Ow[(long)orow * opitch + d0 * 32] = (bf16_t)(cvt_pk_bf16(o[d0][r] * rn * g8[d0], 0.f) & 0xffffu); }
    }
    asm volatile("s_waitcnt vmcnt(0) lgkmcnt(0)" ::: "memory");
    __syncthreads();
#undef TJ
#undef DJ0
#undef CINIT
#undef SLOAD
#undef SWRITE
#undef SWAIT
#undef RESC
}
}

namespace lru {
constexpr int T = 128, PITCH = NPROJ;
constexpr int OFF_XC = 0, OFF_G = 16384, OFF_CAR = OFF_G + T * 128 * 4, OFF_CIN = OFF_CAR + 16 * 64 * 8;
__device__ __forceinline__ int crow(int r, int hi) { return (r & 3) + 8 * (r >> 2) + 4 * hi; }
__device__ __forceinline__ float gelu_tanh(float x) { const float u = 0.7978845608028654f * (x + 0.044715f * x * x * x); return x * fast_sigmoid(2.0f * u); }

template <int DIR, bool DRY = false>
__device__ __forceinline__ void lru_dir(bf16_t* proj, bf16_t* hf, long R0, int S, int n, const float* __restrict__ conv_w, const float* __restrict__ conv_b,
                                        const float* __restrict__ w_rg, const float* __restrict__ b_rg, const float* __restrict__ w_ig, const float* __restrict__ b_ig,
                                        const float* __restrict__ lam, char* lds) {
    int tid = threadIdx.x; asm volatile("" : "+v"(tid));
    const int wid = tid >> 6, lane = tid & 63, r32 = lane & 31, hi = lane >> 5;
    const int cp = tid & 31, tsub = tid >> 5, c0 = 2 * cp;
    float* G = (float*)(lds + OFF_G); f32x2* CAR = (f32x2*)(lds + OFF_CAR); float* CIN = (float*)(lds + OFF_CIN);
    float cw[4][2], cb[2], k1[2];
#pragma unroll
    for (int e = 0; e < 2; ++e) { const int ch = n * 64 + c0 + e;
#pragma unroll
        for (int j = 0; j < 4; ++j) cw[j][e] = conv_w[j * 512 + ch];
        cb[e] = conv_b[ch];
        const float sp = log1pf(expf(-lam[DIR * 512 + ch]));
        k1[e] = -8.0f * sp * LOG2E; }
    const int ct = wid & 3, gtype = ct >> 1, dcol = (ct & 1) * 32 + r32;
    const float* Wg = (gtype ? w_ig : w_rg) + (size_t)(DIR * 8 + n) * 64 * 64;
    const float gbias = (gtype ? b_ig : b_rg)[DIR * 512 + n * 64 + dcol];
    bf16x8 bfr[4];
#pragma unroll
    for (int ks = 0; ks < 4; ++ks) { float wv[8];
#pragma unroll
        for (int j = 0; j < 8; ++j) wv[j] = Wg[(ks * 16 + 8 * hi + j) * 64 + dcol];
        u32x4 w; w.x = cvt_pk_bf16(wv[0], wv[1]); w.y = cvt_pk_bf16(wv[2], wv[3]); w.z = cvt_pk_bf16(wv[4], wv[5]); w.w = cvt_pk_bf16(wv[6], wv[7]);
        bfr[ks] = *reinterpret_cast<bf16x8*>(&w); }
    if (tid < 128) CIN[tid] = 0.f;
    __syncthreads();
    const int NC = S / T;
    unsigned xn_[11], hfn_[8], gtn_[8];
#define LRU_PREFETCH(ci_) do { const int ck_ = DIR ? (NC - 1 - (ci_)) : (ci_); const int tq_ = ck_ * T + 8 * tsub; \
        const bf16_t* xp_ = proj + (R0 + tq_) * PITCH + COL_XR + n * 64 + c0; \
        _Pragma("unroll") for (int k = 2; k < 10; ++k) xn_[k] = *(const unsigned*)(xp_ + (long)(k - 2) * PITCH); \
        { const int lo2 = tq_ - 2 < 0 ? 0 : tq_ - 2, lo1 = tq_ - 1 < 0 ? 0 : tq_ - 1, hi8 = tq_ + 8 >= S ? S - 1 : tq_ + 8; \
          const unsigned a_ = *(const unsigned*)(xp_ + (long)(lo2 - tq_) * PITCH), b_ = *(const unsigned*)(xp_ + (long)(lo1 - tq_) * PITCH), c_ = *(const unsigned*)(xp_ + (long)(hi8 - tq_) * PITCH); \
          xn_[0] = tq_ - 2 < 0 ? 0u : a_; xn_[1] = tq_ - 1 < 0 ? 0u : b_; xn_[10] = tq_ + 8 >= S ? 0u : c_; } \
        if (DIR) { _Pragma("unroll") for (int k = 0; k < 8; ++k) { const long row_ = R0 + tq_ + k; \
            hfn_[k] = *(const unsigned*)(hf + row_ * 512 + n * 64 + c0); gtn_[k] = *(const unsigned*)(proj + row_ * PITCH + COL_G + n * 64 + c0); } } } while (0)
    LRU_PREFETCH(0);
    for (int ci = 0; ci < NC; ++ci) {
        const int ck = DIR ? (NC - 1 - ci) : ci, t0 = ck * T, par = ci & 1;
        float xin[11][2]; unsigned hfv[8], gtv[8];
#pragma unroll
        for (int k = 0; k < 11; ++k) { xin[k][0] = bf16lo(xn_[k]); xin[k][1] = bf16hi(xn_[k]); }
#pragma unroll
        for (int k = 0; k < 8; ++k) { hfv[k] = hfn_[k]; gtv[k] = gtn_[k]; }
        if (ci + 1 < NC) LRU_PREFETCH(ci + 1);
        float xc[8][2];
#pragma unroll
        for (int k = 0; k < 8; ++k)
#pragma unroll
            for (int e = 0; e < 2; ++e) xc[k][e] = cb[e] + cw[0][e] * xin[k][e] + cw[1][e] * xin[k + 1][e] + cw[2][e] * xin[k + 2][e] + cw[3][e] * xin[k + 3][e];
#pragma unroll
        for (int k = 0; k < 8; ++k) { const int tl = 8 * tsub + k;
            *(unsigned*)(lds + OFF_XC + tl * 128 + ((((c0 >> 3) ^ ((tl >> 1) & 7))) << 4) + (c0 & 7) * 2) = cvt_pk_bf16(xc[k][0], xc[k][1]); }
        __syncthreads();
#pragma unroll
        for (int rt2 = 0; rt2 < 2; ++rt2) { const int rt = (wid >> 2) * 2 + rt2; f32x16 acc = {};
#pragma unroll
            for (int ks = 0; ks < 4; ++ks) { const int row = rt * 32 + r32, cbb = ks * 32 + hi * 16;
                const bf16x8 a = *reinterpret_cast<const bf16x8*>(lds + OFF_XC + row * 128 + (cbb ^ (((row >> 1) & 7) << 4)));
                acc = __builtin_amdgcn_mfma_f32_32x32x16_bf16(a, bfr[ks], acc, 0, 0, 0); }
#pragma unroll
            for (int r = 0; r < 16; ++r) G[(rt * 32 + crow(r, hi)) * 128 + ct * 32 + r32] = fast_sigmoid(acc[r] + gbias); }
        __syncthreads();
        float av[8][2], bv[8][2];
#pragma unroll
        for (int k = 0; k < 8; ++k) { const int tl = 8 * tsub + k; const f32x2 rg = *(const f32x2*)&G[tl * 128 + c0], ig = *(const f32x2*)&G[tl * 128 + 64 + c0];
#pragma unroll
            for (int e = 0; e < 2; ++e) { const float l2a = rg[e] * k1[e]; av[k][e] = __builtin_amdgcn_exp2f(l2a);
                const float m2 = fmaxf(__builtin_fmaf(-av[k][e], av[k][e], 1.0f), 1e-12f);
                bv[k][e] = __builtin_amdgcn_sqrtf(m2) * ig[e] * xc[k][e]; } }
        float A[2] = {1.f, 1.f}, Hh[2] = {0.f, 0.f};
#pragma unroll
        for (int kk = 0; kk < 8; ++kk) { const int k = DIR ? 7 - kk : kk;
#pragma unroll
            for (int e = 0; e < 2; ++e) { Hh[e] = av[k][e] * Hh[e] + bv[k][e]; A[e] *= av[k][e]; } }
        CAR[tsub * 64 + c0] = (f32x2){A[0], Hh[0]}; CAR[tsub * 64 + c0 + 1] = (f32x2){A[1], Hh[1]};
        __syncthreads();
        float h[2] = {CIN[par * 64 + c0], CIN[par * 64 + c0 + 1]};
        if (DIR == 0) { for (int s = 0; s < tsub; ++s) { const f32x2 q0 = CAR[s * 64 + c0], q1 = CAR[s * 64 + c0 + 1]; h[0] = q0[0] * h[0] + q0[1]; h[1] = q1[0] * h[1] + q1[1]; } }
        else { for (int s = 15; s > tsub; --s) { const f32x2 q0 = CAR[s * 64 + c0], q1 = CAR[s * 64 + c0 + 1]; h[0] = q0[0] * h[0] + q0[1]; h[1] = q1[0] * h[1] + q1[1]; } }
#pragma unroll
        for (int kk = 0; kk < 8; ++kk) { const int k = DIR ? 7 - kk : kk; const long row = R0 + t0 + 8 * tsub + k;
            h[0] = av[k][0] * h[0] + bv[k][0]; h[1] = av[k][1] * h[1] + bv[k][1];
            if (DIR == 0) { *(unsigned*)(hf + row * 512 + n * 64 + c0) = cvt_pk_bf16(h[0], h[1]); }
            else { const unsigned hv = hfv[k]; unsigned* gp = (unsigned*)(proj + row * PITCH + COL_G + n * 64 + c0); const unsigned gv = gtv[k]; if (DRY) gp = (unsigned*)(hf + row * 512 + n * 64 + c0);
                const float y0 = (bf16lo(hv) + h[0]) * gelu_tanh(bf16lo(gv)), y1 = (bf16hi(hv) + h[1]) * gelu_tanh(bf16hi(gv));
                *gp = cvt_pk_bf16(y0, y1); } }
        if (tsub == (DIR ? 0 : 15)) { CIN[(par ^ 1) * 64 + c0] = h[0]; CIN[(par ^ 1) * 64 + c0 + 1] = h[1]; }
    }
#undef LRU_PREFETCH
    asm volatile("s_waitcnt vmcnt(0) lgkmcnt(0)" ::: "memory");
    __syncthreads();
}
}

typedef __attribute__((address_space(1))) unsigned gu32;
#define RLX_AGENT __ATOMIC_RELAXED, __HIP_MEMORY_SCOPE_AGENT
constexpr int LDSCTL_OFF = 131072, MISC_OFF = LDSCTL_OFF + 320;
constexpr int CW_BAR = 4096, CW_QUEUE = 8192;
#define XB_TMO      128
#define XB_XCNT(j)  (256  + 64 * (j))
#define XB_XSUB(j)  (1280 + 64 * (j))
#define XB_XGEN(j)  (2304 + 64 * (j))
#define XB_TOP      3328
#define XB_TOPGEN   3392
#define XCD_BAR_WORDS 3456
#define XB_SPIN_CAP (1u << 22)
__device__ __forceinline__ unsigned xb_ld(unsigned* p)              { return __hip_atomic_load(p, __ATOMIC_RELAXED, __HIP_MEMORY_SCOPE_AGENT); }
__device__ __forceinline__ unsigned xb_add(unsigned* p, unsigned v) { return __hip_atomic_fetch_add(p, v, __ATOMIC_RELAXED, __HIP_MEMORY_SCOPE_AGENT); }
__device__ __forceinline__ unsigned xb_xcc_id() { return (unsigned)__builtin_amdgcn_s_getreg((3 << 11) | 20) & 0xFu; }
#define XB_SPIN(cond, bar) do { unsigned _sp = 0; while (cond) { __builtin_amdgcn_s_sleep(1); \
    if ((++_sp & 255u) == 0u) { if (xb_ld(&(bar)[XB_TMO])) break; if (_sp > XB_SPIN_CAP) { atomicAdd(&(bar)[XB_TMO], 1u); break; } } } } while (0)
struct XcdBarrier { unsigned* bar; unsigned x; volatile LAS unsigned* st; };
__device__ __forceinline__ XcdBarrier xcd_barrier_post(unsigned* bar, volatile LAS unsigned* st) {
    XcdBarrier b; b.bar = bar; b.x = xb_xcc_id(); b.st = st;
    if (threadIdx.x == 0) (void)xb_add(&bar[XB_XCNT(b.x)], 1u);
    return b;
}
__device__ __forceinline__ void xcd_barrier_complete(unsigned* bar, unsigned x, unsigned& nloc, unsigned& nx) {
    const unsigned G = gridDim.x * gridDim.y * gridDim.z;
    unsigned sum, cnt, mine, sp = 0u;
    for (;;) {
        sum = 0u; cnt = 0u; mine = 0u;
#pragma unroll
        for (unsigned j = 0; j < 16; ++j) { const unsigned c = xb_ld(&bar[XB_XCNT(j)]); sum += c; cnt += (c > 0u) ? 1u : 0u; mine = (j == x) ? c : mine; }
        if (sum == G) break;
        __builtin_amdgcn_s_sleep(1);
        if ((++sp & 255u) == 0u) { if (xb_ld(&bar[XB_TMO])) break; if (sp > XB_SPIN_CAP) { atomicAdd(&bar[XB_TMO], 1u); break; } }
    }
    nloc = mine > 0u ? mine : 1u; nx = cnt > 0u ? cnt : 1u;
}
__device__ __forceinline__ void xcd_barrier(const XcdBarrier& b) {
    asm volatile("s_waitcnt vmcnt(0)" ::: "memory");
    __syncthreads();
    if (threadIdx.x == 0) {
        unsigned* bar = b.bar;
        __builtin_amdgcn_s_waitcnt(0);
        unsigned nloc = b.st[0], nx = b.st[1];
        if (nloc == 0u) { xcd_barrier_complete(bar, b.x, nloc, nx); b.st[0] = nloc; b.st[1] = nx; }
        const unsigned old = xb_add(&bar[XB_XSUB(b.x)], 1u);
        const unsigned gen = old / nloc;
        if (old + 1u == (gen + 1u) * nloc) {
            __builtin_amdgcn_fence(__ATOMIC_RELEASE, "agent");
            asm volatile("s_waitcnt vmcnt(0)" ::: "memory");
            const unsigned og = xb_add(&bar[XB_TOP], 1u);
            const unsigned tg = og / nx;
            if (og + 1u == (tg + 1u) * nx) xb_add(&bar[XB_TOPGEN], 1u);
            else XB_SPIN(xb_ld(&bar[XB_TOPGEN]) == tg, bar);
            __builtin_amdgcn_fence(__ATOMIC_ACQUIRE, "agent");
            xb_add(&bar[XB_XGEN(b.x)], 1u);
            asm volatile("s_waitcnt vmcnt(0)" ::: "memory");
        } else {
            XB_SPIN(xb_ld(&bar[XB_XGEN(b.x)]) == gen, bar);
            __builtin_amdgcn_fence(__ATOMIC_ACQUIRE, "agent");
            asm volatile("s_waitcnt vmcnt(0)" ::: "memory");
        }
    }
    __syncthreads();
}

#ifndef PH_MASK
#define PH_MASK 0x7f
#endif
#ifndef PROBE
#define PROBE 0
#endif
struct Args { const float* in[22]; float* out; unsigned char* ws; };

__device__ __forceinline__ void transpose_item(const float* __restrict__ W, int K, int N, int k0, int n0, bf16_t* WT, int drow0, const float* __restrict__ ksc, float csc, LAS float* scr, int lane) {
#pragma unroll 8
    for (int i = 0; i < 32; ++i) { const int kk = 2 * i + (lane >> 5); const float s = (ksc ? ksc[k0 + kk] : 1.0f) * csc; scr[kk * 33 + (lane & 31)] = W[(size_t)(k0 + kk) * N + n0 + (lane & 31)] * s; }
    asm volatile("s_waitcnt lgkmcnt(0)" ::: "memory");
    const int c = lane & 7;
#pragma unroll
    for (int j = 0; j < 4; ++j) { const int n = (lane >> 3) + 8 * j; const LAS float* s = scr + (8 * c) * 33 + n;
        u32x4 o; o.x = cvt_pk_bf16(s[0 * 33], s[1 * 33]); o.y = cvt_pk_bf16(s[2 * 33], s[3 * 33]); o.z = cvt_pk_bf16(s[4 * 33], s[5 * 33]); o.w = cvt_pk_bf16(s[6 * 33], s[7 * 33]);
        *(u32x4*)(WT + (size_t)(drow0 + n) * K + k0 + 8 * c) = o; }
    asm volatile("s_waitcnt lgkmcnt(0)" ::: "memory");
}

__global__ void __launch_bounds__(NTHREADS, 2) mega_fwd(Args args) {
    extern __shared__ __attribute__((aligned(16))) unsigned char lds[];
    cg::grid_group grid = cg::this_grid();
    const int tid = threadIdx.x, lane = tid & 63, wave = __builtin_amdgcn_readfirstlane(tid >> 6);
    const int G = gridDim.x, bx = blockIdx.x;
    const int vcu = (G % 8 == 0) ? (bx % 8) * (G / 8) + bx / 8 : bx;
    unsigned char* ws = args.ws;
    const float* x_p = args.in[0]; const float* x_s = args.in[1];
    bf16_t* Win_t = (bf16_t*)(ws + WS_WIN); bf16_t* Wout_t = (bf16_t*)(ws + WS_WOUT); bf16_t* Wgu_t = (bf16_t*)(ws + WS_WGU); bf16_t* Wdn_t = (bf16_t*)(ws + WS_WDN);
    float* SSQ = (float*)(ws + WS_SSQ); bf16_t* XN = (bf16_t*)(ws + WS_XN); bf16_t* HF = (bf16_t*)(ws + WS_HF); float* STASH = (float*)(ws + WS_STASH);
    bf16_t* PROJ = (bf16_t*)(ws + WS_PROJ); bf16_t* HB = (bf16_t*)(ws + WS_H);
    float* out = args.out;
    const int gw = vcu * NWAVES + wave, NGW = G * NWAVES;
    unsigned* ctl = (unsigned*)(ws + WS_CTL);
    for (int u = tid; u < (LDS_BYTES - LDSCTL_OFF) / 4; u += NTHREADS) ((LAS unsigned*)((LAS unsigned char*)lds + LDSCTL_OFF))[u] = 0u;
    __syncthreads();
    volatile LAS unsigned* MISC = (volatile LAS unsigned*)((LAS unsigned char*)lds + MISC_OFF);
    const XcdBarrier xbar = xcd_barrier_post(ctl + CW_BAR, MISC + 8);

    if (PH_MASK & 1) {
        LAS float* scr = (LAS float*)((LAS unsigned char*)lds + wave * 16384);
        constexpr int I_IN = 16 * 80, I_OUT = 16 * 32, I_G = 16 * 88, I_U = 16 * 88, I_D = 44 * 32;
        constexpr int NITEMS = I_IN + I_OUT + I_G + I_U + I_D;
        for (int it = gw; it < NITEMS; it += NGW) {
            int r = it;
            if (r < I_IN) { const int kb = r / 80, nb = r % 80, n0 = nb * 32, reg = n0 >> 9, off = n0 & 511;
                const int dbase = reg == 0 ? COL_Q : reg == 1 ? COL_K : reg == 2 ? COL_V : reg == 3 ? COL_XR : COL_G;
                transpose_item(args.in[3], DM, NPROJ, kb * 64, n0, Win_t, dbase + off, nullptr, reg == 0 ? QSCALE : 1.0f, scr, lane); continue; } r -= I_IN;
            if (r < I_OUT) { const int kb = r / 32, nb = r % 32; transpose_item(args.in[16], DM, DM, kb * 64, nb * 32, Wout_t, nb * 32, nullptr, 1.0f, scr, lane); continue; } r -= I_OUT;
            if (r < I_G) { const int kb = r / 88, nb = r % 88, n0 = nb * 32; transpose_item(args.in[18], DM, DFF, kb * 64, n0, Wgu_t, 256 * (n0 >> 7) + (n0 & 127), args.in[17], 1.0f, scr, lane); continue; } r -= I_G;
            if (r < I_U) { const int kb = r / 88, nb = r % 88, n0 = nb * 32; transpose_item(args.in[19], DM, DFF, kb * 64, n0, Wgu_t, 256 * (n0 >> 7) + 128 + (n0 & 127), args.in[17], 1.0f, scr, lane); continue; } r -= I_U;
            { const int kb = r / 32, nb = r % 32; transpose_item(args.in[20], DFF, DM, kb * 64, nb * 32, Wdn_t, nb * 32, nullptr, 1.0f, scr, lane); }
        }
        const f32x4* g4 = (const f32x4*)args.in[2];
        for (int m = gw; m < MTOK; m += NGW) {
            const float* xrow = (m < PROMPT_ROWS) ? x_p + (size_t)m * DM : x_s + (size_t)(m - PROMPT_ROWS) * DM;
            const f32x4* xr = (const f32x4*)xrow + lane; f32x4 v[4]; float s = 0.f;
#pragma unroll
            for (int j = 0; j < 4; ++j) { v[j] = xr[64 * j]; s += (v[j].x * v[j].x + v[j].y * v[j].y) + (v[j].z * v[j].z + v[j].w * v[j].w); }
            const float rstd = __builtin_amdgcn_rsqf(wave_sum(s) * (1.0f / DM) + EPS);
            u32x2* o8 = (u32x2*)(XN + (size_t)m * DM) + lane;
#pragma unroll
            for (int j = 0; j < 4; ++j) { const f32x4 gg = g4[lane + 64 * j]; u32x2 w; w.x = cvt_pk_bf16(v[j].x * rstd * gg.x, v[j].y * rstd * gg.y); w.y = cvt_pk_bf16(v[j].z * rstd * gg.z, v[j].w * rstd * gg.w); o8[64 * j] = w; }
        }
    }
    grid.sync();

    if (PH_MASK & 2) { pg8::Gemm g{XN, Win_t, DM, MTOK, NPROJ, DM}; pg8::StaticOrder S; S.init(MTOK, NPROJ, G, bx);
      pg8::EpiStoreBf16 E{PROJ, NPROJ};
      pg8::gemm_phase(( LAS unsigned char*)lds, g, S, E);
      if (PROBE == 1) { __syncthreads(); pg8::gemm_phase(( LAS unsigned char*)lds, g, S, E); } }
    xcd_barrier(xbar);

    if (PH_MASK & 4) {
        float lam;
        { float s1 = 0.f, s2 = 0.f;
          for (int i = 0; i < 64; ++i) { s1 += args.in[11][i] * args.in[12][i]; s2 += args.in[13][i] * args.in[14][i]; }
          lam = expf(s1) - expf(s2) + 0.2f; }
        float* stash = STASH + (size_t)bx * 256 * 128;
        constexpr int L_AS = 64, L_LS = 8, L_AP = 64, L_LP = 16, L_TOT = L_AS + L_LS + L_AP + L_LP;
        unsigned qcur = xbar.x & 7u, qtried = 0u;
        for (;;) {
            if (tid == 0) { unsigned idx = 0u;
                while (qtried < 8u) { idx = xb_add(ctl + CW_QUEUE + 64 * qcur, 1u); if (idx < (unsigned)L_TOT) break; qcur = (qcur + 1u) & 7u; ++qtried; }
                MISC[16] = (qtried < 8u) ? (qcur * 256u + idx) : 0xffffffffu; }
            __syncthreads();
            const unsigned uv = MISC[16];
            __syncthreads();
            if (uv == 0xffffffffu) break;
            const int lx = (int)(uv >> 8), li = (int)(uv & 255u);
            if (li < L_AS || (li >= L_AS + L_LS && li < L_AS + L_LS + L_AP)) {
#ifndef NO_ATT
                int s, h, qb, S;
                if (li < L_AS) { const int pair = 4 * lx + (li >> 4); s = 16 + (pair >> 2); h = pair & 3; qb = li & 15; S = S_S; }
                else { const int l2 = li - (L_AS + L_LS), pair = 8 * lx + (l2 >> 3); s = pair >> 2; h = pair & 3; qb = l2 & 7; S = S_P; }
                const long R0 = (s < 16) ? (long)s * S_P : (long)PROMPT_ROWS + (long)(s - 16) * S_S;
                const float mp = exp2f(-2.0f * (float)(h + 1)) * LOG2E;
                bf16_t* base = PROJ + R0 * NPROJ;
                bf16_t* Qb = base + (long)(qb * 256) * NPROJ + COL_Q + h * 128;
                const bf16_t* Kh = base + COL_K + h * 128; const bf16_t* Vh = base + COL_V + h * 128;
                const int NT = S / 64, t0 = qb * 4;
                if (PROBE == 2) { bf16_t* dry = (bf16_t*)(ws + 128 * MiB) + (size_t)bx * 256 * 128;
                    att::attn_pass<0>(Qb, Kh, Vh, NT, t0, qb * 256, mp, lam, args.in[15], stash, dry, 128, (char*)lds);
                    att::attn_pass<1>(Qb + 64, Kh + 64, Vh, NT, t0, qb * 256, mp, lam, args.in[15], stash, dry, 128, (char*)lds); }
                att::attn_pass<0>(Qb, Kh, Vh, NT, t0, qb * 256, mp, lam, args.in[15], stash, Qb, NPROJ, (char*)lds);
                att::attn_pass<1>(Qb + 64, Kh + 64, Vh, NT, t0, qb * 256, mp, lam, args.in[15], stash, Qb, NPROJ, (char*)lds);
#endif
            } else {
#ifndef NO_LRU
                int s, n, S;
                if (li < L_AS + L_LS) { s = 16 + lx; n = li - L_AS; S = S_S; }
                else { const int l2 = li - (L_AS + L_LS + L_AP); s = 2 * lx + (l2 >> 3); n = l2 & 7; S = S_P; }
                const long R0 = (s < 16) ? (long)s * S_P : (long)PROMPT_ROWS + (long)(s - 16) * S_S;
                if (PROBE == 3) {
                    lru::lru_dir<0, true>(PROJ, HF, R0, S, n, args.in[4], args.in[5], args.in[6], args.in[7], args.in[8], args.in[9], args.in[10], (char*)lds);
                    lru::lru_dir<1, true>(PROJ, HF, R0, S, n, args.in[4], args.in[5], args.in[6], args.in[7], args.in[8], args.in[9], args.in[10], (char*)lds); }
                lru::lru_dir<0>(PROJ, HF, R0, S, n, args.in[4], args.in[5], args.in[6], args.in[7], args.in[8], args.in[9], args.in[10], (char*)lds);
                lru::lru_dir<1>(PROJ, HF, R0, S, n, args.in[4], args.in[5], args.in[6], args.in[7], args.in[8], args.in[9], args.in[10], (char*)lds);
#endif
            }
        }
    }
    xcd_barrier(xbar);

    if (PH_MASK & 8) { pg8::Gemm g{PROJ, Wout_t, NPROJ, MTOK, DM, DM}; pg8::StaticOrder S; S.init(MTOK, DM, G, bx);
      pg8::EpiResid<true> E{x_p, x_s, out, XN, SSQ};
      pg8::gemm_phase((LAS unsigned char*)lds, g, S, E); }
    xcd_barrier(xbar);

    if (PH_MASK & 16) { pg8::Gemm g{XN, Wgu_t, DM, MTOK, NGU, DM}; pg8::StaticOrder S; S.init(MTOK, NGU, G, bx);
      pg8::EpiSwiGLU E{SSQ, HB};
      pg8::gemm_phase((LAS unsigned char*)lds, g, S, E);
      if (PROBE == 1) { __syncthreads(); pg8::gemm_phase((LAS unsigned char*)lds, g, S, E); } }
    xcd_barrier(xbar);

    if (PH_MASK & 32) { pg8::Gemm g{HB, Wdn_t, DFF, MTOK, DM, DFF}; pg8::StaticOrder S; S.init(MTOK, DM, G, bx);
      pg8::EpiResid<false> E{out, out + (size_t)PROMPT_ROWS * DM, out, nullptr, SSQ};
      pg8::gemm_phase((LAS unsigned char*)lds, g, S, E); }
    xcd_barrier(xbar);

    if (PH_MASK & 64) {
        const f32x4* g4 = (const f32x4*)args.in[21];
        for (int m = gw; m < MTOK; m += NGW) {
            float sv = (lane < 16) ? SSQ[(size_t)m * 16 + lane] : 0.f;
            sv += __shfl_xor(sv, 1); sv += __shfl_xor(sv, 2); sv += __shfl_xor(sv, 4); sv += __shfl_xor(sv, 8);
            const float tot = __shfl(sv, 0);
            const float rstd = __builtin_amdgcn_rsqf(tot * (1.0f / DM) + EPS);
            f32x4* xr = (f32x4*)(out + (size_t)m * DM) + lane;
#pragma unroll
            for (int j = 0; j < 4; ++j) { const f32x4 gg = g4[lane + 64 * j]; f32x4 v = xr[64 * j]; v.x *= rstd * gg.x; v.y *= rstd * gg.y; v.z *= rstd * gg.z; v.w *= rstd * gg.w; xr[64 * j] = v; }
        }
    }
}

extern "C" void kernel_launch(void* const* d_in, const int* in_sizes, int n_in, void* d_out, int out_size, void* d_ws, size_t ws_size, hipStream_t stream) {
    static int grid_blocks = 0;
    if (grid_blocks == 0) {
        if (n_in != 22 || in_sizes[0] != PROMPT_ROWS * DM || in_sizes[1] != PROMPT_ROWS * DM || out_size != MTOK * DM || ws_size < WS_END) {
            fprintf(stderr, "kernel_launch: shape mismatch (n_in %d, in0 %d, out %d, ws %zu)\n", n_in, n_in > 0 ? in_sizes[0] : -1, out_size, ws_size); grid_blocks = -1; return; }
        int dev = 0, cus = 0, per_cu = 0;
        (void)hipGetDevice(&dev);
        (void)hipDeviceGetAttribute(&cus, hipDeviceAttributeMultiprocessorCount, dev);
        if (hipFuncSetAttribute((const void*)mega_fwd, hipFuncAttributeMaxDynamicSharedMemorySize, LDS_BYTES) != hipSuccess) { fprintf(stderr, "kernel_launch: hipFuncSetAttribute failed\n"); grid_blocks = -1; return; }
        if (hipOccupancyMaxActiveBlocksPerMultiprocessor(&per_cu, (const void*)mega_fwd, NTHREADS, LDS_BYTES) != hipSuccess || per_cu < 1) { fprintf(stderr, "kernel_launch: occupancy query failed (%d)\n", per_cu); grid_blocks = -1; return; }
        grid_blocks = cus * 1;
    }
    if (grid_blocks < 0) return;
    if (hipMemsetAsync((char*)d_ws + WS_CTL, 0, CTL_BYTES, stream) != hipSuccess) { fprintf(stderr, "kernel_launch: hipMemsetAsync failed\n"); return; }
    Args a{};
    for (int i = 0; i < 22; ++i) a.in[i] = (const float*)d_in[i];
    a.out = (float*)d_out; a.ws = (unsigned char*)d_ws;
    void* kargs[] = {&a};
    hipError_t e = hipLaunchCooperativeKernel((const void*)mega_fwd, dim3(grid_blocks), dim3(NTHREADS), kargs, LDS_BYTES, stream);
    if (e != hipSuccess) fprintf(stderr, "kernel_launch: cooperative launch failed: %s (grid %d)\n", hipGetErrorString(e), grid_blocks);
}
```
